# Optimizing an MI355X kernel written in HIP

```python
import jax, jax.numpy as jnp
from jax import lax
import numpy as np

D_MODEL = 4096
BATCH = 4
SEQ = 2048
DEPTH = 1

D_MIX = D_MODEL
HEAD_DIM = 128
D_A = D_MIX // 2
D_B = D_MIX - D_A
N_HEADS_A = D_A // HEAD_DIM
N_BLOCKS_B = D_B // HEAD_DIM
CHUNK = 128
CONV_WIDTH = 4
LRU_C = 8.0
D_FF = ((8 * D_MODEL + 3 * 256 - 1) // (3 * 256)) * 256
D_IN = 2 * D_A + 2 * D_B
EPS = 1e-6

kernel_name = "hybrid_gmlp_rglru_sandwich_block"


def rmsnorm(x, g):
    x32 = x.astype(jnp.float32)
    y = x32 * lax.rsqrt(jnp.mean(x32 * x32, axis=-1, keepdims=True) + EPS)
    return (y * g.astype(jnp.float32)).astype(x.dtype)


def gmlp_mixer(u, v, v_norm_g, w_spatial, b_spatial):
    B, S, _ = v.shape
    u = jax.nn.gelu(u)
    v = jax.nn.gelu(v).reshape(B, S, N_HEADS_A, HEAD_DIM)
    v = rmsnorm(v, v_norm_g.reshape(N_HEADS_A, HEAD_DIM))
    vc = v.reshape(B, S // CHUNK, CHUNK, N_HEADS_A, HEAD_DIM)
    causal = jnp.tril(jnp.ones((CHUNK, CHUNK), dtype=bool))
    ws = jnp.where(causal[None], w_spatial, jnp.zeros_like(w_spatial))
    mixed = jnp.einsum('hts,bcshd->bcthd', ws, vc) + b_spatial.T[None, None, :, :, None]
    return u * mixed.reshape(B, S, D_A)


def causal_depthwise_conv(x, w_conv, b_conv):
    S = x.shape[1]
    xpad = jnp.pad(x, ((0, 0), (CONV_WIDTH - 1, 0), (0, 0)))
    out = b_conv
    for k in range(CONV_WIDTH):
        out = out + xpad[:, k:k + S, :] * w_conv[k]
    return out


def block_diag_linear(x, w, b):
    B, S, _ = x.shape
    xb = x.reshape(B, S, N_BLOCKS_B, HEAD_DIM)
    return jnp.einsum('bsnd,nde->bsne', xb, w).reshape(B, S, D_B) + b


def rglru_mixer(gate, xr, w_conv, b_conv, w_r, b_r, w_i, b_i, lru_lambda):
    xc = causal_depthwise_conv(xr, w_conv, b_conv)
    r = jax.nn.sigmoid(block_diag_linear(xc, w_r, b_r)).astype(jnp.float32)
    i = jax.nn.sigmoid(block_diag_linear(xc, w_i, b_i)).astype(jnp.float32)
    log_a = -LRU_C * r * jax.nn.softplus(-lru_lambda.astype(jnp.float32))
    a = jnp.exp(log_a)
    mult = jnp.sqrt(jnp.maximum(1.0 - jnp.exp(2.0 * log_a), 1e-12))
    bterm = mult * (i * xc.astype(jnp.float32))

    def combine(left, right):
        a_l, b_l = left
        a_r, b_r_ = right
        return a_l * a_r, a_r * b_l + b_r_

    _, h = lax.associative_scan(combine, (a, bterm), axis=1)
    return h.astype(xr.dtype) * jax.nn.gelu(gate)


def setup_inputs(seed: int = 0) -> dict:
    key = jax.random.key(seed)
    ks = jax.random.split(key, 24)
    f32 = jnp.float32

    def nrm(k, shape, scale):
        return jax.random.normal(k, shape, f32) * scale

    def gain(k, shape):
        return 1.0 + 0.02 * jax.random.normal(k, shape, f32)

    L = DEPTH
    x = jax.random.normal(ks[0], (BATCH, SEQ, D_MODEL), f32)
    pre_mix_g = gain(ks[1], (L, D_MODEL))
    w_in = nrm(ks[2], (L, D_MODEL, D_IN), D_MODEL ** -0.5)
    gmlp_v_norm_g = gain(ks[3], (L, D_A))
    w_spatial = nrm(ks[4], (L, N_HEADS_A, CHUNK, CHUNK), CHUNK ** -0.5)
    b_spatial = 1.0 + 0.01 * jax.random.normal(ks[5], (L, N_HEADS_A, CHUNK), f32)
    w_conv = nrm(ks[6], (L, CONV_WIDTH, D_B), CONV_WIDTH ** -0.5)
    b_conv = nrm(ks[7], (L, D_B), 0.01)
    w_r = nrm(ks[8], (L, N_BLOCKS_B, HEAD_DIM, HEAD_DIM), HEAD_DIM ** -0.5)
    b_r = nrm(ks[9], (L, D_B), 0.01)
    w_i = nrm(ks[10], (L, N_BLOCKS_B, HEAD_DIM, HEAD_DIM), HEAD_DIM ** -0.5)
    b_i = nrm(ks[11], (L, D_B), 0.01)
    a_c = jax.random.uniform(ks[12], (L, D_B), f32, 0.9, 0.999)
    a0 = a_c ** (1.0 / LRU_C)
    lru_lambda = jnp.log(a0) - jnp.log1p(-a0)
    out_norm_a_g = gain(ks[13], (L, D_A))
    out_norm_b_g = gain(ks[14], (L, D_B))
    w_out = nrm(ks[15], (L, D_MIX, D_MODEL), D_MIX ** -0.5)
    post_mix_g = gain(ks[16], (L, D_MODEL))
    pre_ffn_g = gain(ks[17], (L, D_MODEL))
    w_ffn_in = nrm(ks[18], (L, D_MODEL, 2 * D_FF), D_MODEL ** -0.5)
    w_ffn_out = nrm(ks[19], (L, D_FF, D_MODEL), D_FF ** -0.5)
    post_ffn_g = gain(ks[20], (L, D_MODEL))
    return {"x": x, "pre_mix_g": pre_mix_g, "w_in": w_in, "gmlp_v_norm_g": gmlp_v_norm_g,
            "w_spatial": w_spatial, "b_spatial": b_spatial, "w_conv": w_conv, "b_conv": b_conv,
            "w_r": w_r, "b_r": b_r, "w_i": w_i, "b_i": b_i, "lru_lambda": lru_lambda,
            "out_norm_a_g": out_norm_a_g, "out_norm_b_g": out_norm_b_g, "w_out": w_out,
            "post_mix_g": post_mix_g, "pre_ffn_g": pre_ffn_g, "w_ffn_in": w_ffn_in,
            "w_ffn_out": w_ffn_out, "post_ffn_g": post_ffn_g}


def reference(x, pre_mix_g, w_in, gmlp_v_norm_g, w_spatial, b_spatial, w_conv, b_conv,
              w_r, b_r, w_i, b_i, lru_lambda, out_norm_a_g, out_norm_b_g, w_out,
              post_mix_g, pre_ffn_g, w_ffn_in, w_ffn_out, post_ffn_g):
    for l in range(DEPTH):
        h = rmsnorm(x, pre_mix_g[l])
        proj = jnp.einsum('bsd,de->bse', h, w_in[l])
        u, v, gate, xr = jnp.split(proj, [D_A, 2 * D_A, 2 * D_A + D_B], axis=-1)
        y_a = gmlp_mixer(u, v, gmlp_v_norm_g[l], w_spatial[l], b_spatial[l])
        y_b = rglru_mixer(gate, xr, w_conv[l], b_conv[l], w_r[l], b_r[l],
                          w_i[l], b_i[l], lru_lambda[l])
        y = jnp.concatenate([rmsnorm(y_a, out_norm_a_g[l]),
                             rmsnorm(y_b, out_norm_b_g[l])], axis=-1)
        y = jnp.einsum('bse,ed->bsd', y, w_out[l])
        x = x + rmsnorm(y, post_mix_g[l])
        h = rmsnorm(x, pre_ffn_g[l])
        gu = jnp.einsum('bsd,df->bsf', h, w_ffn_in[l])
        g, up = jnp.split(gu, 2, axis=-1)
        f = jnp.einsum('bsf,fd->bsd', jax.nn.silu(g) * up, w_ffn_out[l])
        x = x + rmsnorm(f, post_ffn_g[l])
    return x
```

```cpp
#include <hip/hip_runtime.h>
#include <hip/hip_cooperative_groups.h>
#include <cstdio>
#include <cstdint>
namespace cg = cooperative_groups;
#ifndef MK_N_LAUNCHES
#define MK_N_LAUNCHES 1
#endif
namespace pg8 {
#define PG8_LAS __attribute__((address_space(3)))
typedef unsigned short bf16_t;
typedef short bf16x8 __attribute__((ext_vector_type(8)));
typedef float f32x4 __attribute__((ext_vector_type(4)));
typedef unsigned u32x4 __attribute__((ext_vector_type(4)));
constexpr int BM = 256, BK = 64, HALF = 128, HTB = HALF * BK * 2  , STAGE_BYTES = 8 * HTB, NXCD = 8, WGM = 8;

__host__ __device__ __forceinline__ int lds_byte(int r, int c) { const int st = (r >> 4) * 2 + (c >> 5), rr = r & 15, cc = c & 31, ob = rr * 64 + cc * 2; return st * 1024 + (ob ^ (((ob >> 9) & 1) << 5)); }
__host__ __device__ __forceinline__ void stage_rc(int b, int& R, int& C) { const int st = b / 1024, sb = b % 1024, swz = sb ^ (((sb >> 9) & 1) << 5); R = (st >> 1) * 16 + swz / 64; C = (st & 1) * 32 + (swz % 64) / 2; }
__host__ __device__ __forceinline__ int perm32(int rho) { const int n = rho >> 4, i = rho & 15; return 8 * (i >> 2) + 4 * n + (i & 3); }

struct Unit { int pm, pn; };
struct Gemm { const bf16_t* A; const bf16_t* Bt; int M, N, K; };

struct StaticOrder {
    int nM, nN, nwg, G, c;
    __host__ __device__ void init(int M, int N, int G_, int c_) { nM = M / BM; nN = N / BM; nwg = nM * nN; G = G_; c = c_; }
    __host__ __device__ bool next(int i, Unit& u) const {
        const long L = (long)i * G + c; if (L >= nwg) return false;
        int wgid = (int)L; { const int q = nwg / NXCD, r = nwg % NXCD, xcd = wgid % NXCD, off = wgid / NXCD; wgid = (xcd < r ? xcd * (q + 1) : r * (q + 1) + (xcd - r) * q) + off; }
        const int nig = WGM * nN, gid = wgid / nig, fm = gid * WGM, gsz = (nM - fm) < WGM ? (nM - fm) : WGM;
        u.pm = fm + ((wgid % nig) % gsz); u.pn = (wgid % nig) / gsz; return true;
    }
    __device__ __forceinline__ void a_ready(const Unit&) const {}
    __device__ __forceinline__ void done(const Unit&) const {}
};
__device__ __forceinline__ unsigned cvt_pk_bf16(float lo, float hi) { unsigned r; asm volatile("v_cvt_pk_bf16_f32 %0, %1, %2" : "=v"(r) : "v"(lo), "v"(hi)); return r; }

template <class Epi, class Sched, bool ALIGN_EPI = false, bool SP2 = false>
__device__ __forceinline__ void gemm_phase(PG8_LAS unsigned char* lds, const Gemm g, const Sched& S, const Epi& E) {
    const int tid = threadIdx.x, wid = __builtin_amdgcn_readfirstlane(tid >> 6), lane = tid & 63, wr = wid >> 2, wc = wid & 3, fr = lane & 15, fq = lane >> 4;
    const int K = g.K, nt = K / BK;
    unsigned voffA[2], voffB[2];
#pragma unroll
    for (int i = 0; i < 2; ++i) { int R, C; stage_rc(tid * 16 + i * 8192, R, C); const int Rb = Epi::PERM ? ((R & ~31) + perm32(R & 31)) : R;
        voffA[i] = (unsigned)(R * K + C) * 2u; voffB[i] = (unsigned)(Rb * K + C) * 2u; }
    const size_t kstep = (size_t)(BK * 2);
    const size_t hstep = (size_t)HALF * K * 2;
    const size_t tstep = 2 * hstep;
    const unsigned ldsw = (unsigned)wid * 1024u;
    const int aoff = lds_byte(wr * 64 + fr, fq * 8), boff = lds_byte(wc * 32 + fr, fq * 8);
#define PG8_SA(b, h) (((b) * 2 + (h)) * HTB)
#define PG8_SB(b, h) ((4 + (b) * 2 + (h)) * HTB)
#define PG8_STAGE(bufoff, gbase, voff) do { _Pragma("unroll") for (int _i = 0; _i < 2; ++_i) \
        __builtin_amdgcn_global_load_lds((const unsigned*)((const char*)(gbase) + (voff)[_i]), (PG8_LAS unsigned*)(lds + (bufoff) + ldsw + _i * 8192), 16, 0, 0); } while (0)
#define PG8_LDA(dst, b, h) do { _Pragma("unroll") for (int m = 0; m < 4; ++m) _Pragma("unroll") for (int k = 0; k < 2; ++k) dst[m][k] = *(const PG8_LAS bf16x8*)(lds + PG8_SA(b, h) + aoff + m * 2048 + k * 1024); } while (0)
#define PG8_LDB(dst, b, h) do { _Pragma("unroll") for (int n = 0; n < 2; ++n) _Pragma("unroll") for (int k = 0; k < 2; ++k) dst[n][k] = *(const PG8_LAS bf16x8*)(lds + PG8_SB(b, h) + boff + n * 2048 + k * 1024); } while (0)
#define PG8_MMA(ai, bj, At, Bt) do { __builtin_amdgcn_s_setprio(1); _Pragma("unroll") for (int m = 0; m < 4; ++m) _Pragma("unroll") for (int n = 0; n < 2; ++n) _Pragma("unroll") for (int k = 0; k < 2; ++k) \
        acc[ai][bj][m][n] = __builtin_amdgcn_mfma_f32_16x16x32_bf16(Bt[n][k], At[m][k], acc[ai][bj][m][n], 0, 0, 0); __builtin_amdgcn_s_setprio(0); } while (0)
#define PG8_WAIT_V(n) asm volatile("s_waitcnt vmcnt(" #n ")" ::: "memory")
#define PG8_WAIT_L(n) asm volatile("s_waitcnt lgkmcnt(" #n ")" ::: "memory")
#define PG8_BAR __builtin_amdgcn_s_barrier()
#define PG8_SCHED __builtin_amdgcn_sched_barrier(0)
    Unit cur, nxt; int ui = 0;
    if (!S.next(0, cur)) return;
    f32x4 acc[2][2][4][2];
#pragma unroll
    for (int a = 0; a < 2; ++a)
#pragma unroll
        for (int b = 0; b < 2; ++b)
#pragma unroll
            for (int m = 0; m < 4; ++m)
#pragma unroll
                for (int n = 0; n < 2; ++n) acc[a][b][m][n] = (f32x4){0.f, 0.f, 0.f, 0.f};
    bf16x8 At[4][2], B0[2][2], B1[2][2];
    const char* cA = (const char*)g.A + (size_t)cur.pm * tstep; const char* cB = (const char*)g.Bt + (size_t)cur.pn * tstep;
    S.a_ready(cur);
    if constexpr (SP2) {
        PG8_STAGE(PG8_SB(0, 0), cB, voffB); PG8_STAGE(PG8_SB(0, 1), cB + hstep, voffB); PG8_STAGE(PG8_SA(0, 0), cA, voffA); PG8_STAGE(PG8_SA(0, 1), cA + hstep, voffA);
        if (wr == 1) PG8_BAR;
        PG8_WAIT_V(2); PG8_BAR;
        PG8_STAGE(PG8_SB(1, 0), cB + kstep, voffB); PG8_STAGE(PG8_SA(1, 0), cA + kstep, voffA); PG8_STAGE(PG8_SB(1, 1), cB + hstep + kstep, voffB);
        PG8_WAIT_V(6); PG8_BAR;
    } else {
        PG8_STAGE(PG8_SB(0, 0), cB, voffB); PG8_STAGE(PG8_SA(0, 0), cA, voffA); PG8_STAGE(PG8_SB(0, 1), cB + hstep, voffB); PG8_STAGE(PG8_SA(0, 1), cA + hstep, voffA);
        if (wr == 1) PG8_BAR;
        PG8_WAIT_V(4); PG8_BAR;
        PG8_STAGE(PG8_SB(1, 0), cB + kstep, voffB); PG8_STAGE(PG8_SA(1, 0), cA + kstep, voffA); PG8_STAGE(PG8_SB(1, 1), cB + hstep + kstep, voffB);
        PG8_WAIT_V(6); PG8_BAR;
    }
    for (;;) {
        const bool has_next = S.next(ui + 1, nxt);
        const char* nA = has_next ? (const char*)g.A + (size_t)nxt.pm * tstep : cA; const char* nB = has_next ? (const char*)g.Bt + (size_t)nxt.pn * tstep : cB;
        for (int t = 0; t < nt; t += 2) {
            if constexpr (Epi::MID) { if (t == (nt >> 1)) E.mid(acc, ui, wr, fr); }
            const bool last = (t == nt - 2);
            const char* a1 = cA + (size_t)(t + 1) * kstep;
            const char* a2 = last ? nA : cA + (size_t)(t + 2) * kstep; const char* b2 = last ? nB : cB + (size_t)(t + 2) * kstep;
            const char* a3 = a2 + kstep; const char* b3 = b2 + kstep;
            if (last && has_next) S.a_ready(nxt);
            if constexpr (SP2) {
            PG8_LDB(B0, 0, 0); PG8_LDB(B1, 0, 1); PG8_SCHED; PG8_LDA(At, 0, 0); PG8_STAGE(PG8_SA(1, 1), a1 + hstep, voffA);
            PG8_WAIT_V(8); PG8_WAIT_L(0); PG8_BAR; PG8_MMA(0, 0, At, B0); PG8_MMA(0, 1, At, B1); PG8_BAR; PG8_SCHED;
            PG8_LDA(At, 0, 1); PG8_STAGE(PG8_SB(0, 0), b2, voffB); PG8_STAGE(PG8_SB(0, 1), b2 + hstep, voffB); PG8_STAGE(PG8_SA(0, 0), a2, voffA);
            PG8_WAIT_V(8); PG8_WAIT_L(0); PG8_BAR; PG8_MMA(1, 0, At, B0); PG8_MMA(1, 1, At, B1); PG8_BAR; PG8_SCHED;
            PG8_LDB(B0, 1, 0); PG8_LDB(B1, 1, 1); PG8_SCHED; PG8_LDA(At, 1, 0); PG8_STAGE(PG8_SA(0, 1), a2 + hstep, voffA);
            PG8_WAIT_V(8); PG8_WAIT_L(0); PG8_BAR; PG8_MMA(0, 0, At, B0); PG8_MMA(0, 1, At, B1); PG8_BAR; PG8_SCHED;
            PG8_LDA(At, 1, 1); PG8_STAGE(PG8_SB(1, 0), b3, voffB); PG8_STAGE(PG8_SB(1, 1), b3 + hstep, voffB); PG8_STAGE(PG8_SA(1, 0), a3, voffA);
            PG8_WAIT_V(8); PG8_WAIT_L(0); PG8_BAR; PG8_MMA(1, 0, At, B0); PG8_MMA(1, 1, At, B1); PG8_BAR; PG8_SCHED;
            } else {
            PG8_LDB(B0, 0, 0); PG8_SCHED; PG8_LDA(At, 0, 0); PG8_STAGE(PG8_SA(1, 1), a1 + hstep, voffA);
            PG8_WAIT_L(8); PG8_BAR; PG8_WAIT_L(0); PG8_MMA(0, 0, At, B0); PG8_BAR; PG8_SCHED;
            PG8_LDB(B1, 0, 1); PG8_STAGE(PG8_SB(0, 0), b2, voffB);
            PG8_BAR; PG8_WAIT_L(0); PG8_MMA(0, 1, At, B1); PG8_BAR;
            PG8_LDA(At, 0, 1); PG8_STAGE(PG8_SA(0, 0), a2, voffA);
            PG8_BAR; PG8_WAIT_L(0); PG8_MMA(1, 0, At, B0); PG8_BAR; PG8_SCHED;
            PG8_STAGE(PG8_SB(0, 1), b2 + hstep, voffB);
            PG8_WAIT_V(6); PG8_BAR; PG8_MMA(1, 1, At, B1); PG8_BAR;
            PG8_LDB(B0, 1, 0); PG8_SCHED; PG8_LDA(At, 1, 0); PG8_STAGE(PG8_SA(0, 1), a2 + hstep, voffA);
            PG8_WAIT_L(8); PG8_BAR; PG8_WAIT_L(0); PG8_MMA(0, 0, At, B0); PG8_BAR; PG8_SCHED;
            PG8_LDB(B1, 1, 1); PG8_STAGE(PG8_SB(1, 0), b3, voffB);
            PG8_BAR; PG8_WAIT_L(0); PG8_MMA(0, 1, At, B1); PG8_BAR;
            PG8_LDA(At, 1, 1); PG8_STAGE(PG8_SA(1, 0), a3, voffA);
            PG8_BAR; PG8_WAIT_L(0); PG8_MMA(1, 0, At, B0); PG8_BAR; PG8_SCHED;
            PG8_STAGE(PG8_SB(1, 1), b3 + hstep, voffB);
            PG8_WAIT_V(6); PG8_BAR; PG8_MMA(1, 1, At, B1); PG8_BAR;
            }
        }
        if constexpr (ALIGN_EPI) { if (wr == 0) PG8_BAR; }
        if constexpr (!Epi::AFTER_DRAIN) { E(acc, cur, ui, wr, wc, fr, fq); S.done(cur); }
        if (!has_next) break;
#pragma unroll
        for (int a = 0; a < 2; ++a)
#pragma unroll
            for (int b = 0; b < 2; ++b)
#pragma unroll
                for (int m = 0; m < 4; ++m)
#pragma unroll
                    for (int n = 0; n < 2; ++n) acc[a][b][m][n] = (f32x4){0.f, 0.f, 0.f, 0.f};
        cur = nxt; cA = nA; cB = nB; ++ui;
        if constexpr (ALIGN_EPI) { if (wr == 1) PG8_BAR; }
    }
    PG8_WAIT_V(0);
    if constexpr (!ALIGN_EPI) { if (wr == 0) PG8_BAR; }
    PG8_BAR;
#undef PG8_SA
#undef PG8_SB
#undef PG8_STAGE
#undef PG8_LDA
#undef PG8_LDB
#undef PG8_MMA
#undef PG8_WAIT_V
#undef PG8_WAIT_L
#undef PG8_BAR
#undef PG8_SCHED
}
}

#define LAS __attribute__((address_space(3)))
typedef unsigned short bf16;
typedef unsigned v4u __attribute__((ext_vector_type(4)));
typedef unsigned v2u __attribute__((ext_vector_type(2)));
typedef float f32x4 __attribute__((ext_vector_type(4)));
typedef float f32x2v __attribute__((ext_vector_type(2)));
typedef short bf16x8 __attribute__((ext_vector_type(8)));

constexpr int NWAVES = 8;
constexpr int M = 8192, D = 4096, DIN = 8192, DA = 2048, DFF = 11008, SEQ = 2048;
constexpr float EPS = 1e-6f, LOG2E = 1.4426950408889634f;
constexpr size_t MiB = 1u << 20;
constexpr size_t WS_WIN = 0, WS_WOUT = 64 * MiB, WS_WFI = 96 * MiB, WS_WFO = 268 * MiB, WS_XN = 354 * MiB, WS_PROJ = 418 * MiB, WS_Y = 546 * MiB,
                 WS_HL = 610 * MiB, WS_PC = 674 * MiB, WS_O1 = 738 * MiB, WS_ACT = 802 * MiB, WS_SSA = 974 * MiB, WS_SSB = WS_SSA + 512 * 1024,
                 WS_SS1 = 975 * MiB, WS_SS2 = 977 * MiB, WS_AGGP = 979 * MiB, WS_AGGH = 980 * MiB, WS_SP = 981 * MiB, WS_CTL = 982 * MiB, WS_END = 983 * MiB;
constexpr size_t CTL_ZERO_BYTES = 65536;
constexpr int RING_BYTES = 131072, RSL_OFF = RING_BYTES, MISC_OFF = RING_BYTES + 16384, LDS_BYTES = MISC_OFF + 256;

#define LDS_WAIT() asm volatile("s_waitcnt lgkmcnt(0)" ::: "memory")
__device__ __forceinline__ unsigned cvtpk(float lo, float hi) { return pg8::cvt_pk_bf16(lo, hi); }
__device__ __forceinline__ float bflo(unsigned w) { return __builtin_bit_cast(float, w << 16); }
__device__ __forceinline__ float bfhi(unsigned w) { return __builtin_bit_cast(float, w & 0xffff0000u); }
__device__ __forceinline__ float wave_sum(float v) {
#pragma unroll
    for (int o = 1; o < 64; o <<= 1) v += __shfl_xor(v, o);
    return v;
}
__device__ __forceinline__ float fexp2(float x) { return __builtin_amdgcn_exp2f(x); }
__device__ __forceinline__ float frcp(float x) { return __builtin_amdgcn_rcpf(x); }
__device__ __forceinline__ float gelu_tanh(float x) { const float z = x * (1.0f + 0.044715f * x * x); return x * frcp(1.0f + fexp2(-2.302208198f * z)); }
__device__ __forceinline__ float sigmoidf_(float x) { return frcp(1.0f + fexp2(-LOG2E * x)); }
template <int CTRL> __device__ __forceinline__ float dpp_f(float old, float src) {
    return __builtin_bit_cast(float, __builtin_amdgcn_update_dpp(__builtin_bit_cast(int, old), __builtin_bit_cast(int, src), CTRL, 0xf, 0xf, false));
}

namespace pg8 {
struct EpiProj {
    static constexpr bool PERM = true, AFTER_DRAIN = false, MID = false;
    bf16_t* O;
    __device__ __forceinline__ void mid(f32x4 (&)[2][2][4][2], int, int, int) const {}
    __device__ __forceinline__ void operator()(const f32x4 (&acc)[2][2][4][2], const Unit& u, int ui, int wr, int wc, int fr, int fq) const {
        const bool act = u.pn < 24;
        const int row0 = u.pm * BM + wr * 64 + fr, col0 = u.pn * BM + wc * 32 + 8 * fq;
#pragma unroll
        for (int ai = 0; ai < 2; ++ai)
#pragma unroll
            for (int m = 0; m < 4; ++m) { bf16_t* rowp = O + (size_t)(row0 + ai * HALF + m * 16) * DIN + col0;
#pragma unroll
                for (int bj = 0; bj < 2; ++bj) { f32x4 v0 = acc[ai][bj][m][0], v1 = acc[ai][bj][m][1];
                    if (act) {
#pragma unroll
                        for (int j = 0; j < 4; ++j) { v0[j] = gelu_tanh(v0[j]); v1[j] = gelu_tanh(v1[j]); } }
                    u32x4 w; w.x = cvt_pk_bf16(v0[0], v0[1]); w.y = cvt_pk_bf16(v0[2], v0[3]); w.z = cvt_pk_bf16(v1[0], v1[1]); w.w = cvt_pk_bf16(v1[2], v1[3]);
                    *(u32x4*)(rowp + bj * HALF) = w; } }
    }
};
template <bool SCALE> struct EpiRows {
    static constexpr bool PERM = true, AFTER_DRAIN = false, MID = SCALE;
    bf16_t* O; float* SS; PG8_LAS unsigned char* rsl;
    __device__ __forceinline__ void mid(f32x4 (&acc)[2][2][4][2], int ui, int wr, int fr) const {
        typedef float f2 __attribute__((ext_vector_type(2)));
#pragma unroll
        for (int ai = 0; ai < 2; ++ai)
#pragma unroll
            for (int m = 0; m < 4; ++m) { const int rl = ai * HALF + wr * 64 + m * 16 + fr; const f2 s = *(const PG8_LAS f2*)(rsl + (size_t)(ui * 256 + rl) * 8);
#pragma unroll
                for (int bj = 0; bj < 2; ++bj)
#pragma unroll
                    for (int n = 0; n < 2; ++n) acc[ai][bj][m][n] = acc[ai][bj][m][n] * s.x; }
    }
    __device__ __forceinline__ void operator()(const f32x4 (&acc)[2][2][4][2], const Unit& u, int ui, int wr, int wc, int fr, int fq) const {
        typedef float f2 __attribute__((ext_vector_type(2)));
        const int row0 = u.pm * BM + wr * 64 + fr, col0 = u.pn * BM + wc * 32 + 8 * fq;
#pragma unroll
        for (int ai = 0; ai < 2; ++ai)
#pragma unroll
            for (int m = 0; m < 4; ++m) { const int rl = ai * HALF + wr * 64 + m * 16 + fr; const int row = u.pm * BM + rl;
                float sc = 1.0f; if (SCALE) { const f2 s = *(const PG8_LAS f2*)(rsl + (size_t)(ui * 256 + rl) * 8); sc = s.y; }
                bf16_t* rowp = O + (size_t)row * 4096 + col0; float ss = 0.f;
#pragma unroll
                for (int bj = 0; bj < 2; ++bj) { const f32x4 v0 = acc[ai][bj][m][0] * sc, v1 = acc[ai][bj][m][1] * sc;
                    ss += (v0[0] * v0[0] + v0[1] * v0[1]) + (v0[2] * v0[2] + v0[3] * v0[3]) + (v1[0] * v1[0] + v1[1] * v1[1]) + (v1[2] * v1[2] + v1[3] * v1[3]);
                    u32x4 w; w.x = cvt_pk_bf16(v0[0], v0[1]); w.y = cvt_pk_bf16(v0[2], v0[3]); w.z = cvt_pk_bf16(v1[0], v1[1]); w.w = cvt_pk_bf16(v1[2], v1[3]);
                    *(u32x4*)(rowp + bj * HALF) = w; }
                ss += __shfl_xor(ss, 16); ss += __shfl_xor(ss, 32);
                if (fq == 0) SS[(size_t)row * 64 + u.pn * 4 + wc] = ss; }
    }
};
struct EpiSwiGLU {
    static constexpr bool PERM = true, AFTER_DRAIN = false, MID = false;
    bf16_t* O;
    __device__ __forceinline__ void mid(f32x4 (&)[2][2][4][2], int, int, int) const {}
    __device__ __forceinline__ void operator()(const f32x4 (&acc)[2][2][4][2], const Unit& u, int ui, int wr, int wc, int fr, int fq) const {
        const int row0 = u.pm * BM + wr * 64 + fr, col0 = u.pn * HALF + wc * 32 + 8 * fq;
#pragma unroll
        for (int ai = 0; ai < 2; ++ai)
#pragma unroll
            for (int m = 0; m < 4; ++m) { bf16_t* rowp = O + (size_t)(row0 + ai * HALF + m * 16) * 11008 + col0;
                f32x4 v0, v1;
#pragma unroll
                for (int j = 0; j < 4; ++j) { const float g0 = acc[ai][0][m][0][j], g1 = acc[ai][0][m][1][j];
                    v0[j] = g0 * __builtin_amdgcn_rcpf(1.0f + __builtin_amdgcn_exp2f(-1.4426950408889634f * g0)) * acc[ai][1][m][0][j];
                    v1[j] = g1 * __builtin_amdgcn_rcpf(1.0f + __builtin_amdgcn_exp2f(-1.4426950408889634f * g1)) * acc[ai][1][m][1][j]; }
                u32x4 w; w.x = cvt_pk_bf16(v0[0], v0[1]); w.y = cvt_pk_bf16(v0[2], v0[3]); w.z = cvt_pk_bf16(v1[0], v1[1]); w.w = cvt_pk_bf16(v1[2], v1[3]);
                *(u32x4*)rowp = w; }
    }
};
}

__device__ __forceinline__ void p0_load_item(f32x4 (&v)[16], const float* src, size_t N, int lane) {
    const float* p = src + (size_t)(lane >> 4) * N + 4 * (lane & 15);
#pragma unroll
    for (int i = 0; i < 16; ++i) v[i] = __builtin_nontemporal_load((const f32x4*)(p + (size_t)(4 * i) * N));
}
template <bool NT> __device__ __forceinline__ void p0_store_item(const f32x4 (&v)[16], bf16* dst, size_t K, LAS float* scr, int lane) {
    const int r = lane >> 4, c = lane & 15;
#pragma unroll
    for (int i = 0; i < 16; ++i) { LAS float* s = scr + (4 * i + r) * 65 + 4 * c; s[0] = v[i].x; s[1] = v[i].y; s[2] = v[i].z; s[3] = v[i].w; }
    LDS_WAIT(); asm volatile("" ::: "memory");
    const int c8 = lane & 7;
#pragma unroll
    for (int j = 0; j < 8; ++j) { const int n = (lane >> 3) + 8 * j; const LAS float* s = scr + (8 * c8) * 65 + n;
        v4u o; o.x = cvtpk(s[0 * 65], s[1 * 65]); o.y = cvtpk(s[2 * 65], s[3 * 65]); o.z = cvtpk(s[4 * 65], s[5 * 65]); o.w = cvtpk(s[6 * 65], s[7 * 65]);
        if (NT) __builtin_nontemporal_store(o, (v4u*)(dst + (size_t)n * K + 8 * c8)); else *(v4u*)(dst + (size_t)n * K + 8 * c8) = o; }
    LDS_WAIT(); asm volatile("" ::: "memory");
}
__device__ __forceinline__ void rms_row_to_bf16(const float* xrow, const float* g, bf16* orow, int lane) {
    const f32x4* xr = (const f32x4*)xrow + lane;
    f32x4 v[16]; float s = 0.f;
#pragma unroll
    for (int j = 0; j < 16; ++j) { v[j] = __builtin_nontemporal_load(xr + 64 * j); s += (v[j].x * v[j].x + v[j].y * v[j].y) + (v[j].z * v[j].z + v[j].w * v[j].w); }
    const float rs = 1.0f / sqrtf(wave_sum(s) * (1.0f / D) + EPS);
    v2u* o8 = (v2u*)orow + lane; const f32x4* gp = (const f32x4*)g + lane;
#pragma unroll
    for (int j = 0; j < 16; ++j) { const f32x4 gg = gp[64 * j]; v2u o; o.x = cvtpk(v[j].x * rs * gg.x, v[j].y * rs * gg.y); o.y = cvtpk(v[j].z * rs * gg.z, v[j].w * rs * gg.w); o8[64 * j] = o; }
}

__device__ __forceinline__ void gmlp_unit(LAS unsigned char* lds, int unit, const bf16* PROJ, const float* WSP, const float* BSP, const float* GV, const float* GOA, bf16* Y, float* SSA) {
    const int tid = threadIdx.x, lane = tid & 63, w = __builtin_amdgcn_readfirstlane(tid >> 6), c16 = lane & 15, q = lane >> 4;
    const int h = unit & 15, tok0 = (unit >> 4) * 128;
    LAS bf16* VT = (LAS bf16*)lds;
    const int trow = 16 * w + c16, nks = (16 * w + 15) / 32 + 1;
    f32x4 wq[4][2];
#pragma unroll
    for (int ks = 0; ks < 4; ++ks) { wq[ks][0] = (f32x4){0.f, 0.f, 0.f, 0.f}; wq[ks][1] = wq[ks][0];
        if (ks < nks) { const float* wp = WSP + ((size_t)h * 128 + trow) * 128 + 32 * ks + 8 * q; wq[ks][0] = *(const f32x4*)wp; wq[ks][1] = *(const f32x4*)(wp + 4); } }
    v2u uq[8];
#pragma unroll
    for (int db = 0; db < 8; ++db) uq[db] = *(const v2u*)(PROJ + (size_t)(tok0 + 16 * w + c16) * DIN + h * 128 + 16 * db + 4 * q);
    {   const int c = tid & 15;
#pragma unroll
        for (int i = 0; i < 4; ++i) { const int s = (tid >> 4) + 32 * i;
            const v4u raw = *(const v4u*)(PROJ + (size_t)(tok0 + s) * DIN + 2048 + h * 128 + 8 * c);
            float f[8]; f[0] = bflo(raw.x); f[1] = bfhi(raw.x); f[2] = bflo(raw.y); f[3] = bfhi(raw.y); f[4] = bflo(raw.z); f[5] = bfhi(raw.z); f[6] = bflo(raw.w); f[7] = bfhi(raw.w);
            float ss = 0.f;
#pragma unroll
            for (int k = 0; k < 8; ++k) ss += f[k] * f[k];
            ss += __shfl_xor(ss, 1); ss += __shfl_xor(ss, 2); ss += __shfl_xor(ss, 4); ss += __shfl_xor(ss, 8);
            const float rs = 1.0f / sqrtf(ss * (1.0f / 128.0f) + EPS);
#pragma unroll
            for (int k = 0; k < 4; ++k) { const unsigned pk = cvtpk(f[2 * k] * rs, f[2 * k + 1] * rs);
                const int sp_ = (((s >> 3) ^ c) << 3) | (s & 7);
                VT[(8 * c + 2 * k) * 136 + sp_] = (bf16)(pk & 0xffffu); VT[(8 * c + 2 * k + 1) * 136 + sp_] = (bf16)(pk >> 16); } }
    }
    __syncthreads();
    f32x4 acc[8];
#pragma unroll
    for (int db = 0; db < 8; ++db) acc[db] = (f32x4){0.f, 0.f, 0.f, 0.f};
#pragma unroll
    for (int ks = 0; ks < 4; ++ks) if (ks < nks) {
        const f32x4 w0 = wq[ks][0], w1 = wq[ks][1];
        const int sb = 32 * ks + 8 * q;
        float wv[8] = {w0.x, w0.y, w0.z, w0.w, w1.x, w1.y, w1.z, w1.w};
#pragma unroll
        for (int j = 0; j < 8; ++j) wv[j] = (sb + j <= trow) ? wv[j] : 0.f;
        v4u wpk; wpk.x = cvtpk(wv[0], wv[1]); wpk.y = cvtpk(wv[2], wv[3]); wpk.z = cvtpk(wv[4], wv[5]); wpk.w = cvtpk(wv[6], wv[7]);
        const bf16x8 wf = __builtin_bit_cast(bf16x8, wpk);
#pragma unroll
        for (int db = 0; db < 8; ++db) { const bf16x8 vf = *(const LAS bf16x8*)(VT + (16 * db + c16) * 136 + (((4 * ks + q) ^ ((16 * db + c16) >> 3)) << 3));
            acc[db] = __builtin_amdgcn_mfma_f32_16x16x32_bf16(vf, wf, acc[db], 0, 0, 0); }
    }
    const int tok = tok0 + 16 * w + c16; const float bsp = BSP[h * 128 + 16 * w + c16]; float ssq = 0.f;
#pragma unroll
    for (int db = 0; db < 8; ++db) { const int dcol = h * 128 + 16 * db + 4 * q;
        const v2u ur = uq[db]; const f32x4 g = *(const f32x4*)(GV + dcol);
        const float y0 = bflo(ur.x) * (g.x * acc[db][0] + bsp), y1 = bfhi(ur.x) * (g.y * acc[db][1] + bsp), y2 = bflo(ur.y) * (g.z * acc[db][2] + bsp), y3 = bfhi(ur.y) * (g.w * acc[db][3] + bsp);
        ssq += (y0 * y0 + y1 * y1) + (y2 * y2 + y3 * y3);
        const f32x4 go = *(const f32x4*)(GOA + dcol); v2u o; o.x = cvtpk(y0 * go.x, y1 * go.y); o.y = cvtpk(y2 * go.z, y3 * go.w); *(v2u*)(Y + (size_t)tok * D + dcol) = o; }
    ssq += __shfl_xor(ssq, 16); ssq += __shfl_xor(ssq, 32);
    if (q == 0) SSA[(size_t)tok * 16 + h] = ssq;
    __syncthreads();
}

__device__ __forceinline__ void rglru_local_unit(LAS unsigned char* lds, int unit, const bf16* PROJ, const float* WR, const float* WI, const float* BR, const float* BI,
                                                 const float* WCONV, const float* BCONV, const float* SP, float* HL, float* PC, float* AGGP, float* AGGH) {
    const int tid = threadIdx.x, lane = tid & 63, w = __builtin_amdgcn_readfirstlane(tid >> 6), c16 = lane & 15, q = lane >> 4;
    const int n = unit & 15, tg = unit >> 4;
#pragma unroll 2
    for (int i = 0; i < 8; ++i) {
        const int f = tid + 512 * i, l2 = f & 63, ks = (f >> 6) & 3, eb = (f >> 8) & 7, mat = f >> 11, i2 = l2 & 15, q2 = l2 >> 4;
        const int e = 32 * (eb >> 1) + 8 * (i2 >> 2) + 4 * (eb & 1) + (i2 & 3);
        const float* src = (mat ? WI : WR) + ((size_t)n * 128 + 32 * ks + 8 * q2) * 128 + e;
        v4u o; o.x = cvtpk(src[0], src[128]); o.y = cvtpk(src[256], src[384]); o.z = cvtpk(src[512], src[640]); o.w = cvtpk(src[768], src[896]);
        *(LAS v4u*)(lds + (size_t)f * 16) = o;
    }
    __syncthreads();
    const int token0 = tg * 512 + w * 64, gc = token0 >> 6;
    LAS f32x2v* cst = (LAS f32x2v*)(lds + 65536 + w * 1024) + q * 32;
#pragma unroll
    for (int i = 0; i < 32; ++i) if (c16 == 15) cst[i] = (f32x2v){1.0f, 0.0f};
#pragma unroll 1
    for (int tb = 0; tb < 4; ++tb) {
        const int tok = token0 + 16 * tb + c16, s = tok & (SEQ - 1);
        int zo = 0; asm volatile("" : "+v"(zo));
        const float* BCONV_ = BCONV + zo; const float* WCONV_ = WCONV + zo; const float* BR_ = BR + zo; const float* BI_ = BI + zo; const float* SP_ = SP + zo;
        float xc[4][8]; bf16x8 xf[4];
#pragma unroll
        for (int ks = 0; ks < 4; ++ks) {
            const int ch0 = n * 128 + 32 * ks + 8 * q;
            const f32x4 b0 = *(const f32x4*)(BCONV_ + ch0), b1 = *(const f32x4*)(BCONV_ + ch0 + 4);
            float a[8] = {b0.x, b0.y, b0.z, b0.w, b1.x, b1.y, b1.z, b1.w};
#pragma unroll
            for (int k = 0; k < 4; ++k) {
                v4u raw = (v4u){0u, 0u, 0u, 0u};
                if (s - 3 + k >= 0) raw = *(const v4u*)(PROJ + (size_t)(tok - 3 + k) * DIN + 6144 + ch0);
                const f32x4 w0 = *(const f32x4*)(WCONV_ + k * 2048 + ch0), w1 = *(const f32x4*)(WCONV_ + k * 2048 + ch0 + 4);
                a[0] += w0.x * bflo(raw.x); a[1] += w0.y * bfhi(raw.x); a[2] += w0.z * bflo(raw.y); a[3] += w0.w * bfhi(raw.y);
                a[4] += w1.x * bflo(raw.z); a[5] += w1.y * bfhi(raw.z); a[6] += w1.z * bflo(raw.w); a[7] += w1.w * bfhi(raw.w);
            }
#pragma unroll
            for (int j = 0; j < 8; ++j) xc[ks][j] = a[j];
            v4u pk; pk.x = cvtpk(a[0], a[1]); pk.y = cvtpk(a[2], a[3]); pk.z = cvtpk(a[4], a[5]); pk.w = cvtpk(a[6], a[7]);
            xf[ks] = __builtin_bit_cast(bf16x8, pk);
        }
#pragma unroll
        for (int ebh = 0; ebh < 2; ++ebh) {
            f32x4 ar[4], ai[4];
#pragma unroll
            for (int e4 = 0; e4 < 4; ++e4) { ar[e4] = (f32x4){0.f, 0.f, 0.f, 0.f}; ai[e4] = (f32x4){0.f, 0.f, 0.f, 0.f}; }
#pragma unroll
            for (int e4 = 0; e4 < 4; ++e4)
#pragma unroll
                for (int ks = 0; ks < 4; ++ks) { const int eb = 4 * ebh + e4;
                    const bf16x8 wfr = *(const LAS bf16x8*)(lds + (size_t)(((0 * 8 + eb) * 4 + ks) * 64 + lane) * 16);
                    const bf16x8 wfi = *(const LAS bf16x8*)(lds + (size_t)(((1 * 8 + eb) * 4 + ks) * 64 + lane) * 16);
                    ar[e4] = __builtin_amdgcn_mfma_f32_16x16x32_bf16(wfr, xf[ks], ar[e4], 0, 0, 0);
                    ai[e4] = __builtin_amdgcn_mfma_f32_16x16x32_bf16(wfi, xf[ks], ai[e4], 0, 0, 0); }
#pragma unroll
            for (int e4 = 0; e4 < 4; ++e4) { const int eb = 4 * ebh + e4, ksx = eb >> 1, jj0 = 4 * (eb & 1), ch = n * 128 + 32 * ksx + 8 * q + jj0;
                const f32x4 br = *(const f32x4*)(BR_ + ch), bi = *(const f32x4*)(BI_ + ch), sp = *(const f32x4*)(SP_ + ch);
                f32x4 hv, pv;
#pragma unroll
                for (int j = 0; j < 4; ++j) {
                    const float r = sigmoidf_(ar[e4][j] + br[j]), ig = sigmoidf_(ai[e4][j] + bi[j]);
                    const float la = -8.0f * r * sp[j];
                    float a = fexp2(la * LOG2E);
                    const float x2 = 2.0f * la;
                    float pm = 1.0f / 720.0f; pm = pm * x2 + 1.0f / 120.0f; pm = pm * x2 + 1.0f / 24.0f; pm = pm * x2 + 1.0f / 6.0f; pm = pm * x2 + 0.5f; pm = pm * x2 + 1.0f; pm = pm * x2;
                    const float m2 = (x2 > -0.25f) ? -pm : (1.0f - a * a);
                    float b = sqrtf(fmaxf(m2, 1e-12f)) * (ig * xc[ksx][jj0 + j]);
                    { float ap = dpp_f<0x111>(1.0f, a), bp = dpp_f<0x111>(0.0f, b); ap = (c16 >= 1) ? ap : 1.0f; bp = (c16 >= 1) ? bp : 0.0f; b = a * bp + b; a = a * ap; }
                    { float ap = dpp_f<0x112>(1.0f, a), bp = dpp_f<0x112>(0.0f, b); ap = (c16 >= 2) ? ap : 1.0f; bp = (c16 >= 2) ? bp : 0.0f; b = a * bp + b; a = a * ap; }
                    { float ap = dpp_f<0x114>(1.0f, a), bp = dpp_f<0x114>(0.0f, b); ap = (c16 >= 4) ? ap : 1.0f; bp = (c16 >= 4) ? bp : 0.0f; b = a * bp + b; a = a * ap; }
                    { float ap = dpp_f<0x118>(1.0f, a), bp = dpp_f<0x118>(0.0f, b); ap = (c16 >= 8) ? ap : 1.0f; bp = (c16 >= 8) ? bp : 0.0f; b = a * bp + b; a = a * ap; }
                    const int ci = eb * 4 + j;
                    const f32x2v cr = cst[ci];
                    const float P = a * cr.x, H = b + a * cr.y;
                    pv[j] = P; hv[j] = H;
                    if (c16 == 15) cst[ci] = (f32x2v){P, H};
                }
                const size_t di = ((((size_t)gc * 16 + n) * 4 + tb) * 8 + eb) * 64 + lane;
                { v4u o; o.x = cvtpk(hv[0], hv[1]); o.y = cvtpk(hv[2], hv[3]); o.z = cvtpk(pv[0], pv[1]); o.w = cvtpk(pv[2], pv[3]); __builtin_nontemporal_store(o, (v4u*)HL + di); }
                if (tb == 3 && c16 == 15) { *(f32x4*)(AGGP + (size_t)gc * 2048 + ch) = pv; *(f32x4*)(AGGH + (size_t)gc * 2048 + ch) = hv; }
            }
        }
    }
    __syncthreads();
}

__device__ __forceinline__ void rglru_final_unit(int unit, const bf16* PROJ, const float* HL, const float* PC, const float* AGGP, const float* AGGH, const float* GOB, bf16* Y, float* SSB) {
    const int tid = threadIdx.x, lane = tid & 63, w = __builtin_amdgcn_readfirstlane(tid >> 6), c16 = lane & 15, q = lane >> 4;
    const int n = unit & 15, tg = unit >> 4;
    const int token0 = tg * 512 + w * 64, gc = token0 >> 6, cin = gc & 31, gb = gc - cin;
    float carry[32];
#pragma unroll
    for (int i = 0; i < 32; ++i) carry[i] = 0.f;
    for (int cp = 0; cp < cin; ++cp) {
#pragma unroll
        for (int eb = 0; eb < 8; ++eb) { const int ch = n * 128 + 32 * (eb >> 1) + 8 * q + 4 * (eb & 1);
            const f32x4 ap = *(const f32x4*)(AGGP + (size_t)(gb + cp) * 2048 + ch), ah = *(const f32x4*)(AGGH + (size_t)(gb + cp) * 2048 + ch);
#pragma unroll
            for (int j = 0; j < 4; ++j) carry[4 * eb + j] = ah[j] + ap[j] * carry[4 * eb + j]; }
    }
#pragma unroll 1
    for (int tb = 0; tb < 4; ++tb) {
        const int tok = token0 + 16 * tb + c16; float ssq = 0.f;
#pragma unroll
        for (int eb = 0; eb < 8; ++eb) { const int chl = 32 * (eb >> 1) + 8 * q + 4 * (eb & 1);
            const size_t di = ((((size_t)gc * 16 + n) * 4 + tb) * 8 + eb) * 64 + lane;
            const v4u hp = __builtin_nontemporal_load((const v4u*)HL + di); const f32x4 hv = (f32x4){bflo(hp.x), bfhi(hp.x), bflo(hp.y), bfhi(hp.y)}, pv = (f32x4){bflo(hp.z), bfhi(hp.z), bflo(hp.w), bfhi(hp.w)};
            const v2u gr = *(const v2u*)(PROJ + (size_t)tok * DIN + 4096 + n * 128 + chl);
            const float y0 = (hv[0] + pv[0] * carry[4 * eb + 0]) * bflo(gr.x), y1 = (hv[1] + pv[1] * carry[4 * eb + 1]) * bfhi(gr.x),
                        y2 = (hv[2] + pv[2] * carry[4 * eb + 2]) * bflo(gr.y), y3 = (hv[3] + pv[3] * carry[4 * eb + 3]) * bfhi(gr.y);
            ssq += (y0 * y0 + y1 * y1) + (y2 * y2 + y3 * y3);
            const f32x4 go = *(const f32x4*)(GOB + n * 128 + chl); v2u o; o.x = cvtpk(y0 * go.x, y1 * go.y); o.y = cvtpk(y2 * go.z, y3 * go.w); *(v2u*)(Y + (size_t)tok * D + 2048 + n * 128 + chl) = o; }
        ssq += __shfl_xor(ssq, 16); ssq += __shfl_xor(ssq, 32);
        if (q == 0) SSB[(size_t)tok * 16 + n] = ssq;
    }
}

#define XB_TMO      128
#define XB_XCNT(j)  (256  + 64 * (j))
#define XB_XSUB(j)  (1280 + 64 * (j))
#define XB_XGEN(j)  (2304 + 64 * (j))
#define XB_TOP      3328
#define XB_TOPGEN   3392
#define XCD_BAR_WORDS 3456
#define XB_SPIN_CAP (1u << 18)

__device__ __forceinline__ unsigned xb_ld(unsigned* p)              { return __hip_atomic_load(p, __ATOMIC_RELAXED, __HIP_MEMORY_SCOPE_AGENT); }
__device__ __forceinline__ unsigned xb_add(unsigned* p, unsigned v) { return __hip_atomic_fetch_add(p, v, __ATOMIC_RELAXED, __HIP_MEMORY_SCOPE_AGENT); }
__device__ __forceinline__ unsigned xb_xcc_id() { return (unsigned)__builtin_amdgcn_s_getreg((3 << 11) | 20) & 0xFu; }
#define XB_SPIN(cond, bar) do { unsigned _sp = 0; while (cond) { __builtin_amdgcn_s_sleep(1); \
    if ((++_sp & 255u) == 0u) { if (xb_ld(&(bar)[XB_TMO])) break; if (_sp > XB_SPIN_CAP) { atomicAdd(&(bar)[XB_TMO], 1u); break; } } } } while (0)

struct XcdBarrier {
    unsigned* bar; unsigned x;
    volatile LAS unsigned* st;
};

__device__ __forceinline__ XcdBarrier xcd_barrier_post(unsigned* bar, volatile LAS unsigned* st) {
    XcdBarrier b; b.bar = bar; b.x = xb_xcc_id(); b.st = st;
    if (threadIdx.x == 0) (void)xb_add(&bar[XB_XCNT(b.x)], 1u);
    return b;
}
__device__ __forceinline__ void xcd_barrier_complete(unsigned* bar, unsigned x, unsigned& nloc, unsigned& nx) {
    const unsigned G = gridDim.x * gridDim.y * gridDim.z;
    unsigned sum, cnt, mine, sp = 0u;
    for (;;) {
        sum = 0u; cnt = 0u; mine = 0u;
#pragma unroll
        for (unsigned j = 0; j < 16; ++j) { const unsigned c = xb_ld(&bar[XB_XCNT(j)]); sum += c; cnt += (c > 0u) ? 1u : 0u; mine = (j == x) ? c : mine; }
        if (sum == G) break;
        __builtin_amdgcn_s_sleep(1);
        if ((++sp & 255u) == 0u) { if (xb_ld(&bar[XB_TMO])) break; if (sp > XB_SPIN_CAP) { atomicAdd(&bar[XB_TMO], 1u); break; } }
    }
    nloc = mine > 0u ? mine : 1u; nx = cnt > 0u ? cnt : 1u;
}

__device__ __forceinline__ void xcd_barrier(const XcdBarrier& b) {
    asm volatile("s_waitcnt vmcnt(0)" ::: "memory");
    __syncthreads();
    if (threadIdx.x == 0) {
        unsigned* bar = b.bar;
        __builtin_amdgcn_s_waitcnt(0);
        unsigned nloc = b.st[0], nx = b.st[1];
        if (nloc == 0u) { xcd_barrier_complete(bar, b.x, nloc, nx); b.st[0] = nloc; b.st[1] = nx; }
        const unsigned old = xb_add(&bar[XB_XSUB(b.x)], 1u);
        const unsigned gen = old / nloc;
        if (old + 1u == (gen + 1u) * nloc) {
            __builtin_amdgcn_fence(__ATOMIC_RELEASE, "agent");
            asm volatile("s_waitcnt vmcnt(0)" ::: "memory");
            const unsigned og = xb_add(&bar[XB_TOP], 1u);
            const unsigned tg = og / nx;
            if (og + 1u == (tg + 1u) * nx) xb_add(&bar[XB_TOPGEN], 1u);
            else XB_SPIN(xb_ld(&bar[XB_TOPGEN]) == tg, bar);
            __builtin_amdgcn_fence(__ATOMIC_ACQUIRE, "agent");
            xb_add(&bar[XB_XGEN(b.x)], 1u);
            asm volatile("s_waitcnt vmcnt(0)" ::: "memory");
        } else {
            XB_SPIN(xb_ld(&bar[XB_XGEN(b.x)]) == gen, bar);
            __builtin_amdgcn_fence(__ATOMIC_ACQUIRE, "agent");
            asm volatile("s_waitcnt vmcnt(0)" ::: "memory");
        }
    }
    __syncthreads();
}

struct Args { const float* in[21]; float* out; unsigned char* ws; int ph_lo, ph_hi; };
constexpr int N_PHASES = 9;

__global__ void __launch_bounds__(NWAVES * 64, 2) mk_fwd(Args args) {
    extern __shared__ __attribute__((aligned(16))) unsigned char lds_raw[];
    LAS unsigned char* lds = (LAS unsigned char*)lds_raw;
    const int tid = threadIdx.x, lane = tid & 63, wave = __builtin_amdgcn_readfirstlane(tid >> 6);
    const int G = gridDim.x, bx = blockIdx.x, gw = bx * NWAVES + wave, NGW = G * NWAVES;
    unsigned char* ws = args.ws;
    const float* x = args.in[0]; float* out = args.out;
    bf16* WinT = (bf16*)(ws + WS_WIN); bf16* WoutT = (bf16*)(ws + WS_WOUT); bf16* WfiT = (bf16*)(ws + WS_WFI); bf16* WfoT = (bf16*)(ws + WS_WFO);
    bf16* XN = (bf16*)(ws + WS_XN); bf16* PROJ = (bf16*)(ws + WS_PROJ); bf16* Y = (bf16*)(ws + WS_Y); bf16* O1 = (bf16*)(ws + WS_O1); bf16* ACT = (bf16*)(ws + WS_ACT);
    float* HL = (float*)(ws + WS_HL); float* PC = (float*)(ws + WS_PC); bf16* FB = (bf16*)(ws + WS_PC); float* SSA = (float*)(ws + WS_SSA); float* SSB = (float*)(ws + WS_SSB);
    float* SS1 = (float*)(ws + WS_SS1); float* SS2 = (float*)(ws + WS_SS2); float* AGGP = (float*)(ws + WS_AGGP); float* AGGH = (float*)(ws + WS_AGGH); float* SP = (float*)(ws + WS_SP);
    const int lo = args.ph_lo, hi = args.ph_hi;
    if (hi > 1000) cg::this_grid().sync();
    volatile LAS unsigned* MISC = (volatile LAS unsigned*)(lds + MISC_OFF);
    if (tid < 64) MISC[tid] = 0u;
    __syncthreads();
    XcdBarrier bar; bar.bar = (unsigned*)(ws + WS_CTL); bar.x = 0; bar.st = nullptr;
    if (hi - lo > 1) bar = xcd_barrier_post((unsigned*)(ws + WS_CTL), MISC);
#ifndef PH_MASK
#define PH_MASK 0x1ff
#endif
#define IN(k) (((PH_MASK >> (k)) & 1) && lo <= (k) && (k) < hi)
#ifndef PROBE_DUP
#define PROBE_DUP 0
#endif
#ifndef PROBE_SYNC
#define PROBE_SYNC 1
#endif
#define NREP(k) (1 + ((PROBE_DUP >> (k)) & 1))
#define SEAM(k) do { if (IN(k) && IN((k) + 1)) { for (int r_ = 0; r_ < PROBE_SYNC; ++r_) xcd_barrier(bar); } } while (0)

    LAS float* scr = (LAS float*)(lds + wave * 16640);
    constexpr int I_IN = (D / 64) * (DIN / 64), I_OUT = (D / 64) * (D / 64), I_FI = (D / 64) * (2 * DFF / 64), I_FO = (DFF / 64) * (D / 64), NITEMS = I_IN + I_OUT + I_FI + I_FO;
    constexpr int CONV_WG_ITEMS = (NITEMS - I_IN) / 32;
    static_assert((NITEMS - I_IN) % 32 == 0, "deferred conversion items");
#define P0_DECODE(it_, src_, dst_, N_, K_) do { int r_ = (it_); \
            if (r_ < I_IN) { const int kb = r_ / (DIN / 64), nb = r_ % (DIN / 64); N_ = DIN; K_ = D; src_ = args.in[2] + (size_t)(64 * kb) * DIN + 64 * nb; dst_ = WinT + (size_t)(64 * nb) * D + 64 * kb; } \
            else if ((r_ -= I_IN) < I_OUT) { const int kb = r_ / (D / 64), nb = r_ % (D / 64); N_ = D; K_ = D; src_ = args.in[15] + (size_t)(64 * kb) * D + 64 * nb; dst_ = WoutT + (size_t)(64 * nb) * D + 64 * kb; } \
            else if ((r_ -= I_OUT) < I_FI) { const int kb = r_ / (2 * DFF / 64), nb = r_ % (2 * DFF / 64), n0d = 64 * nb, pn = n0d >> 8, within = n0d & 255; const int n0s = (within < 128 ? 0 : DFF) + 128 * pn + (within & 127); \
                N_ = 2 * DFF; K_ = D; src_ = args.in[18] + (size_t)(64 * kb) * (2 * DFF) + n0s; dst_ = WfiT + (size_t)n0d * D + 64 * kb; } \
            else { r_ -= I_FI; const int kb = r_ / (D / 64), nb = r_ % (D / 64); N_ = D; K_ = DFF; src_ = args.in[19] + (size_t)(64 * kb) * D + 64 * nb; dst_ = WfoT + (size_t)(64 * nb) * DFF + 64 * kb; } } while (0)
#define CONVERT_RANGE(first_, end_, stride_, nt_) do { \
            f32x4 nxt[16]; const float* src = nullptr; bf16* dst = nullptr; size_t N = 0, K = 0; \
            int it = (first_); bool have = it < (end_); \
            if (have) { P0_DECODE(it, src, dst, N, K); p0_load_item(nxt, src, N, lane); } \
            while (have) { \
                f32x4 cur[16]; \
                _Pragma("unroll") for (int i = 0; i < 16; ++i) cur[i] = nxt[i]; \
                bf16* cdst = dst; const size_t cK = K; \
                it += (stride_); have = it < (end_); \
                if (have) { P0_DECODE(it, src, dst, N, K); p0_load_item(nxt, src, N, lane); } \
                p0_store_item<nt_>(cur, cdst, cK, scr, lane); \
            } } while (0)
#define WG_FETCH(ctr_, out_) do { __syncthreads(); if (tid == 0) MISC[16] = __hip_atomic_fetch_add((ctr_), 1u, __ATOMIC_RELAXED, __HIP_MEMORY_SCOPE_AGENT); __syncthreads(); out_ = (int)MISC[16]; } while (0)

    if (IN(0)) for (int rep = 0; rep < NREP(0); ++rep) {
        CONVERT_RANGE(gw, I_IN, NGW, false);
        for (int m = gw; m < M; m += NGW) rms_row_to_bf16(x + (size_t)m * D, args.in[1], XN + (size_t)m * D, lane);
        for (int i = bx * 512 + tid; i < 2048; i += G * 512) SP[i] = log1pf(expf(-args.in[12][i]));
    }
    SEAM(0);
    if (IN(1)) for (int rep = 0; rep < NREP(1); ++rep) {
        pg8::Gemm g{XN, WinT, M, DIN, D}; pg8::StaticOrder S; S.init(M, DIN, G, bx);
        pg8::EpiProj E{PROJ};
        pg8::gemm_phase<pg8::EpiProj, pg8::StaticOrder, false, true>(lds, g, S, E);
    }
    SEAM(1);
    if (IN(2)) for (int rep = 0; rep < NREP(2); ++rep) {
        unsigned* qmix = (unsigned*)(ws + WS_CTL) + 8192 + 256 * rep; unsigned* qconv = qmix + 64;
        const bool conv_first = ((bx >> 3) & 7) >= 2;
        for (int pass = 0; pass < 2; ++pass) {
            if ((pass == 0) == conv_first) {
                for (;;) { int ci; WG_FETCH(qconv, ci); if (ci >= CONV_WG_ITEMS) break;
                    const int first = I_IN + ci * 32 + wave; CONVERT_RANGE(first, I_IN + ci * 32 + 32, 8, true); }
            } else {
                for (;;) { int u; WG_FETCH(qmix, u); if (u >= 1280) break;
                    if (u < 256) rglru_local_unit(lds, u, PROJ, args.in[8], args.in[10], args.in[9], args.in[11], args.in[6], args.in[7], SP, HL, PC, AGGP, AGGH);
                    else gmlp_unit(lds, u - 256, PROJ, args.in[4], args.in[5], args.in[3], args.in[13], Y, SSA); }
            }
        }
        __syncthreads();
    }
    SEAM(2);
    if (IN(3)) for (int rep = 0; rep < NREP(3); ++rep) {
        for (int u = bx; u < 256; u += G) rglru_final_unit(u, PROJ, HL, PC, AGGP, AGGH, args.in[14], Y, SSB);
    }
    SEAM(3);
    if (IN(4)) for (int rep = 0; rep < NREP(4); ++rep) {
        pg8::Gemm g{Y, WoutT, M, D, D}; pg8::StaticOrder S; S.init(M, D, G, bx);
        { pg8::Unit u;
          for (int i = 0; i < 8 && S.next(i, u); ++i) {
              if (tid < 256) { const int row = u.pm * 256 + tid; const f32x4* pa = (const f32x4*)(SSA + (size_t)row * 16); const f32x4* pb = (const f32x4*)(SSB + (size_t)row * 16);
                  float sa = 0.f, sb = 0.f;
#pragma unroll
                  for (int j = 0; j < 4; ++j) { const f32x4 a = pa[j], b = pb[j]; sa += (a.x + a.y) + (a.z + a.w); sb += (b.x + b.y) + (b.z + b.w); }
                  const float rsa = 1.0f / sqrtf(sa * (1.0f / DA) + EPS), rsb = 1.0f / sqrtf(sb * (1.0f / DA) + EPS);
                  *(LAS f32x2v*)(lds + RSL_OFF + (size_t)(i * 256 + tid) * 8) = (f32x2v){rsa / rsb, rsb}; } }
          __syncthreads(); }
        pg8::EpiRows<true> E{O1, SS1, lds + RSL_OFF};
        pg8::gemm_phase<pg8::EpiRows<true>, pg8::StaticOrder, false, true>(lds, g, S, E);
    }
    SEAM(4);
    if (IN(5)) for (int rep = 0; rep < NREP(5); ++rep) {
        for (int row = gw; row < M; row += NGW) {
            const float rs1 = 1.0f / sqrtf(wave_sum(SS1[(size_t)row * 64 + lane]) * (1.0f / D) + EPS);
            f32x4 x1[16]; float s2 = 0.f;
#pragma unroll
            for (int j = 0; j < 16; ++j) { const int col = 4 * lane + 256 * j;
                const f32x4 xv = __builtin_nontemporal_load((const f32x4*)(x + (size_t)row * D + col)); const v2u o = *(const v2u*)(O1 + (size_t)row * D + col); const f32x4 g = *(const f32x4*)(args.in[16] + col);
                f32x4 v; v.x = xv.x + bflo(o.x) * rs1 * g.x; v.y = xv.y + bfhi(o.x) * rs1 * g.y; v.z = xv.z + bflo(o.y) * rs1 * g.z; v.w = xv.w + bfhi(o.y) * rs1 * g.w;
                x1[j] = v; s2 += (v.x * v.x + v.y * v.y) + (v.z * v.z + v.w * v.w); }
            const float rs2 = 1.0f / sqrtf(wave_sum(s2) * (1.0f / D) + EPS);
#pragma unroll
            for (int j = 0; j < 16; ++j) { const int col = 4 * lane + 256 * j; const f32x4 g = *(const f32x4*)(args.in[17] + col);
                v2u o; o.x = cvtpk(x1[j].x * rs2 * g.x, x1[j].y * rs2 * g.y); o.y = cvtpk(x1[j].z * rs2 * g.z, x1[j].w * rs2 * g.w);
                *(v2u*)(XN + (size_t)row * D + col) = o; }
        }
    }
    SEAM(5);
    if (IN(6)) for (int rep = 0; rep < NREP(6); ++rep) {
        pg8::Gemm g{XN, WfiT, M, 2 * DFF, D}; pg8::StaticOrder S; S.init(M, 2 * DFF, G, bx);
        pg8::EpiSwiGLU E{ACT};
        pg8::gemm_phase<pg8::EpiSwiGLU, pg8::StaticOrder, false, true>(lds, g, S, E);
    }
    SEAM(6);
    if (IN(7)) for (int rep = 0; rep < NREP(7); ++rep) {
        pg8::Gemm g{ACT, WfoT, M, D, DFF}; pg8::StaticOrder S; S.init(M, D, G, bx);
        pg8::EpiRows<false> E{FB, SS2, lds + RSL_OFF};
        pg8::gemm_phase<pg8::EpiRows<false>, pg8::StaticOrder, false, true>(lds, g, S, E);
    }
    SEAM(7);
    if (IN(8)) for (int rep = 0; rep < NREP(8); ++rep) {
        float* dst = (rep + 1 == NREP(8)) ? out : (float*)(ws + WS_HL);
        for (int row = gw; row < M; row += NGW) {
            const float rs = 1.0f / sqrtf(wave_sum(SS2[(size_t)row * 64 + lane]) * (1.0f / D) + EPS);
            const float rs1 = 1.0f / sqrtf(wave_sum(SS1[(size_t)row * 64 + lane]) * (1.0f / D) + EPS);
#pragma unroll
            for (int j = 0; j < 16; ++j) { const int col = 4 * lane + 256 * j;
                const f32x4 xv = __builtin_nontemporal_load((const f32x4*)(x + (size_t)row * D + col)); const v2u o1 = *(const v2u*)(O1 + (size_t)row * D + col); const f32x4 g1 = *(const f32x4*)(args.in[16] + col);
                const v2u o = *(const v2u*)(FB + (size_t)row * D + col); const f32x4 g = *(const f32x4*)(args.in[20] + col);
                f32x4 v; v.x = xv.x + bflo(o1.x) * rs1 * g1.x; v.y = xv.y + bfhi(o1.x) * rs1 * g1.y; v.z = xv.z + bflo(o1.y) * rs1 * g1.z; v.w = xv.w + bfhi(o1.y) * rs1 * g1.w;
                v.x = v.x + bflo(o.x) * rs * g.x; v.y = v.y + bfhi(o.x) * rs * g.y; v.z = v.z + bflo(o.y) * rs * g.z; v.w = v.w + bfhi(o.y) * rs * g.w;
                __builtin_nontemporal_store(v, (f32x4*)(dst + (size_t)row * D + col)); }
        }
    }
#undef IN
#undef SEAM
#undef P0_DECODE
#undef CONVERT_RANGE
#undef WG_FETCH
}

extern "C" void kernel_launch(void* const* d_in, const int* in_sizes, int n_in, void* d_out, int out_size, void* d_ws, size_t ws_size, hipStream_t stream) {
    static int grid = 0;
    if (grid == 0) {
        if (n_in != 21 || out_size != M * D || ws_size < WS_END) { fprintf(stderr, "kernel_launch: unexpected problem (n_in %d, out %d, ws %zu)\n", n_in, out_size, ws_size); grid = -1; return; }
        int dev = 0, cus = 0, per_cu = 0;
        if (hipGetDevice(&dev) != hipSuccess || hipDeviceGetAttribute(&cus, hipDeviceAttributeMultiprocessorCount, dev) != hipSuccess) { grid = -1; return; }
        if (hipFuncSetAttribute((const void*)mk_fwd, hipFuncAttributeMaxDynamicSharedMemorySize, LDS_BYTES) != hipSuccess) { fprintf(stderr, "kernel_launch: hipFuncSetAttribute failed\n"); grid = -1; return; }
        if (hipOccupancyMaxActiveBlocksPerMultiprocessor(&per_cu, (const void*)mk_fwd, NWAVES * 64, LDS_BYTES) != hipSuccess || per_cu < 1) per_cu = 1;
        (void)hipGetLastError();
        grid = cus * per_cu;
        fprintf(stderr, "kernel_launch: %d CUs x %d -> grid %d\n", cus, per_cu, grid);
    }
    if (grid < 0) return;
    if (hipMemsetAsync((char*)d_ws + WS_CTL, 0, CTL_ZERO_BYTES, stream) != hipSuccess) { fprintf(stderr, "kernel_launch: hipMemsetAsync failed\n"); return; }
    Args a{};
    for (int i = 0; i < 21; ++i) a.in[i] = (const float*)d_in[i];
    a.out = (float*)d_out; a.ws = (unsigned char*)d_ws;
#if MK_N_LAUNCHES == 1
    a.ph_lo = 0; a.ph_hi = N_PHASES;
    void* kargs[] = {&a};
    hipError_t e = hipLaunchCooperativeKernel((const void*)mk_fwd, dim3(grid), dim3(NWAVES * 64), kargs, LDS_BYTES, stream);
    if (e != hipSuccess) fprintf(stderr, "kernel_launch: cooperative launch failed: %s (grid %d)\n", hipGetErrorString(e), grid);
#else
    for (int p = 0; p < N_PHASES; ++p) { a.ph_lo = p; a.ph_hi = p + 1; hipLaunchKernelGGL(mk_fwd, dim3(grid), dim3(NWAVES * 64), LDS_BYTES, stream, a); }
#endif
}
```

```cpp
#include <hip/hip_runtime.h>
#include <hip/hip_cooperative_groups.h>
#include <cstdio>
#include <cstdint>
namespace cg = cooperative_groups;
#ifndef MK_N_LAUNCHES
#define MK_N_LAUNCHES 1
#endif
namespace pg8 {
#define PG8_LAS __attribute__((address_space(3)))
typedef unsigned short bf16_t;
typedef short bf16x8 __attribute__((ext_vector_type(8)));
typedef float f32x4 __attribute__((ext_vector_type(4)));
typedef unsigned u32x4 __attribute__((ext_vector_type(4)));
constexpr int BM = 256, BK = 64, HALF = 128, HTB = HALF * BK * 2  , STAGE_BYTES = 8 * HTB, NXCD = 8, WGM = 8;

__host__ __device__ __forceinline__ int lds_byte(int r, int c) { const int st = (r >> 4) * 2 + (c >> 5), rr = r & 15, cc = c & 31, ob = rr * 64 + cc * 2; return st * 1024 + (ob ^ (((ob >> 9) & 1) << 5)); }
__host__ __device__ __forceinline__ void stage_rc(int b, int& R, int& C) { const int st = b / 1024, sb = b % 1024, swz = sb ^ (((sb >> 9) & 1) << 5); R = (st >> 1) * 16 + swz / 64; C = (st & 1) * 32 + (swz % 64) / 2; }
__host__ __device__ __forceinline__ int perm32(int rho) { const int n = rho >> 4, i = rho & 15; return 8 * (i >> 2) + 4 * n + (i & 3); }

struct Unit { int pm, pn; };
struct Gemm { const bf16_t* A; const bf16_t* Bt; int M, N, K; };

struct StaticOrder {
    int nM, nN, nwg, G, c;
    __host__ __device__ void init(int M, int N, int G_, int c_) { nM = M / BM; nN = N / BM; nwg = nM * nN; G = G_; c = c_; }
    __host__ __device__ bool next(int i, Unit& u) const {
        const long L = (long)i * G + c; if (L >= nwg) return false;
        int wgid = (int)L; { const int q = nwg / NXCD, r = nwg % NXCD, xcd = wgid % NXCD, off = wgid / NXCD; wgid = (xcd < r ? xcd * (q + 1) : r * (q + 1) + (xcd - r) * q) + off; }
        const int nig = WGM * nN, gid = wgid / nig, fm = gid * WGM, gsz = (nM - fm) < WGM ? (nM - fm) : WGM;
        u.pm = fm + ((wgid % nig) % gsz); u.pn = (wgid % nig) / gsz; return true;
    }
    __device__ __forceinline__ void a_ready(const Unit&) const {}
    __device__ __forceinline__ void done(const Unit&) const {}
};
__device__ __forceinline__ unsigned cvt_pk_bf16(float lo, float hi) { unsigned r; asm volatile("v_cvt_pk_bf16_f32 %0, %1, %2" : "=v"(r) : "v"(lo), "v"(hi)); return r; }

template <class Epi, class Sched, bool ALIGN_EPI = false, bool SP2 = false>
__device__ __forceinline__ void gemm_phase(PG8_LAS unsigned char* lds, const Gemm g, const Sched& S, const Epi& E) {
    const int tid = threadIdx.x, wid = __builtin_amdgcn_readfirstlane(tid >> 6), lane = tid & 63, wr = wid >> 2, wc = wid & 3, fr = lane & 15, fq = lane >> 4;
    const int K = g.K, nt = K / BK;
    unsigned voffA[2], voffB[2];
#pragma unroll
    for (int i = 0; i < 2; ++i) { int R, C; stage_rc(tid * 16 + i * 8192, R, C); const int Rb = Epi::PERM ? ((R & ~31) + perm32(R & 31)) : R;
        voffA[i] = (unsigned)(R * K + C) * 2u; voffB[i] = (unsigned)(Rb * K + C) * 2u; }
    const size_t kstep = (size_t)(BK * 2);
    const size_t hstep = (size_t)HALF * K * 2;
    const size_t tstep = 2 * hstep;
    const unsigned ldsw = (unsigned)wid * 1024u;
    const int aoff = lds_byte(wr * 64 + fr, fq * 8), boff = lds_byte(wc * 32 + fr, fq * 8);
#define PG8_SA(b, h) (((b) * 2 + (h)) * HTB)
#define PG8_SB(b, h) ((4 + (b) * 2 + (h)) * HTB)
#define PG8_STAGE(bufoff, gbase, voff) do { _Pragma("unroll") for (int _i = 0; _i < 2; ++_i) \
        __builtin_amdgcn_global_load_lds((const unsigned*)((const char*)(gbase) + (voff)[_i]), (PG8_LAS unsigned*)(lds + (bufoff) + ldsw + _i * 8192), 16, 0, 0); } while (0)
#define PG8_LDA(dst, b, h) do { _Pragma("unroll") for (int m = 0; m < 4; ++m) _Pragma("unroll") for (int k = 0; k < 2; ++k) dst[m][k] = *(const PG8_LAS bf16x8*)(lds + PG8_SA(b, h) + aoff + m * 2048 + k * 1024); } while (0)
#define PG8_LDB(dst, b, h) do { _Pragma("unroll") for (int n = 0; n < 2; ++n) _Pragma("unroll") for (int k = 0; k < 2; ++k) dst[n][k] = *(const PG8_LAS bf16x8*)(lds + PG8_SB(b, h) + boff + n * 2048 + k * 1024); } while (0)
#define PG8_MMA(ai, bj, At, Bt) do { __builtin_amdgcn_s_setprio(1); _Pragma("unroll") for (int m = 0; m < 4; ++m) _Pragma("unroll") for (int n = 0; n < 2; ++n) _Pragma("unroll") for (int k = 0; k < 2; ++k) \
        acc[ai][bj][m][n] = __builtin_amdgcn_mfma_f32_16x16x32_bf16(Bt[n][k], At[m][k], acc[ai][bj][m][n], 0, 0, 0); __builtin_amdgcn_s_setprio(0); } while (0)
#define PG8_WAIT_V(n) asm volatile("s_waitcnt vmcnt(" #n ")" ::: "memory")
#define PG8_WAIT_L(n) asm volatile("s_waitcnt lgkmcnt(" #n ")" ::: "memory")
#define PG8_BAR __builtin_amdgcn_s_barrier()
#define PG8_SCHED __builtin_amdgcn_sched_barrier(0)
    Unit cur, nxt; int ui = 0;
    if (!S.next(0, cur)) return;
    f32x4 acc[2][2][4][2];
#pragma unroll
    for (int a = 0; a < 2; ++a)
#pragma unroll
        for (int b = 0; b < 2; ++b)
#pragma unroll
            for (int m = 0; m < 4; ++m)
#pragma unroll
                for (int n = 0; n < 2; ++n) acc[a][b][m][n] = (f32x4){0.f, 0.f, 0.f, 0.f};
    bf16x8 At[4][2], B0[2][2], B1[2][2];
    const char* cA = (const char*)g.A + (size_t)cur.pm * tstep; const char* cB = (const char*)g.Bt + (size_t)cur.pn * tstep;
    S.a_ready(cur);
    if constexpr (SP2) {
        PG8_STAGE(PG8_SB(0, 0), cB, voffB); PG8_STAGE(PG8_SB(0, 1), cB + hstep, voffB); PG8_STAGE(PG8_SA(0, 0), cA, voffA); PG8_STAGE(PG8_SA(0, 1), cA + hstep, voffA);
        if (wr == 1) PG8_BAR;
        PG8_WAIT_V(2); PG8_BAR;
        PG8_STAGE(PG8_SB(1, 0), cB + kstep, voffB); PG8_STAGE(PG8_SA(1, 0), cA + kstep, voffA); PG8_STAGE(PG8_SB(1, 1), cB + hstep + kstep, voffB);
        PG8_WAIT_V(6); PG8_BAR;
    } else {
        PG8_STAGE(PG8_SB(0, 0), cB, voffB); PG8_STAGE(PG8_SA(0, 0), cA, voffA); PG8_STAGE(PG8_SB(0, 1), cB + hstep, voffB); PG8_STAGE(PG8_SA(0, 1), cA + hstep, voffA);
        if (wr == 1) PG8_BAR;
        PG8_WAIT_V(4); PG8_BAR;
        PG8_STAGE(PG8_SB(1, 0), cB + kstep, voffB); PG8_STAGE(PG8_SA(1, 0), cA + kstep, voffA); PG8_STAGE(PG8_SB(1, 1), cB + hstep + kstep, voffB);
        PG8_WAIT_V(6); PG8_BAR;
    }
    for (;;) {
        const bool has_next = S.next(ui + 1, nxt);
        const char* nA = has_next ? (const char*)g.A + (size_t)nxt.pm * tstep : cA; const char* nB = has_next ? (const char*)g.Bt + (size_t)nxt.pn * tstep : cB;
        for (int t = 0; t < nt; t += 2) {
            if constexpr (Epi::MID) { if (t == (nt >> 1)) E.mid(acc, ui, wr, fr); }
            const bool last = (t == nt - 2);
            const char* a1 = cA + (size_t)(t + 1) * kstep;
            const char* a2 = last ? nA : cA + (size_t)(t + 2) * kstep; const char* b2 = last ? nB : cB + (size_t)(t + 2) * kstep;
            const char* a3 = a2 + kstep; const char* b3 = b2 + kstep;
            if (last && has_next) S.a_ready(nxt);
            if constexpr (SP2) {
            PG8_LDB(B0, 0, 0); PG8_LDB(B1, 0, 1); PG8_SCHED; PG8_LDA(At, 0, 0); PG8_STAGE(PG8_SA(1, 1), a1 + hstep, voffA);
            PG8_WAIT_V(8); PG8_WAIT_L(0); PG8_BAR; PG8_MMA(0, 0, At, B0); PG8_MMA(0, 1, At, B1); PG8_BAR; PG8_SCHED;
            PG8_LDA(At, 0, 1); PG8_STAGE(PG8_SB(0, 0), b2, voffB); PG8_STAGE(PG8_SB(0, 1), b2 + hstep, voffB); PG8_STAGE(PG8_SA(0, 0), a2, voffA);
            PG8_WAIT_V(8); PG8_WAIT_L(0); PG8_BAR; PG8_MMA(1, 0, At, B0); PG8_MMA(1, 1, At, B1); PG8_BAR; PG8_SCHED;
            PG8_LDB(B0, 1, 0); PG8_LDB(B1, 1, 1); PG8_SCHED; PG8_LDA(At, 1, 0); PG8_STAGE(PG8_SA(0, 1), a2 + hstep, voffA);
            PG8_WAIT_V(8); PG8_WAIT_L(0); PG8_BAR; PG8_MMA(0, 0, At, B0); PG8_MMA(0, 1, At, B1); PG8_BAR; PG8_SCHED;
            PG8_LDA(At, 1, 1); PG8_STAGE(PG8_SB(1, 0), b3, voffB); PG8_STAGE(PG8_SB(1, 1), b3 + hstep, voffB); PG8_STAGE(PG8_SA(1, 0), a3, voffA);
            PG8_WAIT_V(8); PG8_WAIT_L(0); PG8_BAR; PG8_MMA(1, 0, At, B0); PG8_MMA(1, 1, At, B1); PG8_BAR; PG8_SCHED;
            } else {
            PG8_LDB(B0, 0, 0); PG8_SCHED; PG8_LDA(At, 0, 0); PG8_STAGE(PG8_SA(1, 1), a1 + hstep, voffA);
            PG8_WAIT_L(8); PG8_BAR; PG8_WAIT_L(0); PG8_MMA(0, 0, At, B0); PG8_BAR; PG8_SCHED;
            PG8_LDB(B1, 0, 1); PG8_STAGE(PG8_SB(0, 0), b2, voffB);
            PG8_BAR; PG8_WAIT_L(0); PG8_MMA(0, 1, At, B1); PG8_BAR;
            PG8_LDA(At, 0, 1); PG8_STAGE(PG8_SA(0, 0), a2, voffA);
            PG8_BAR; PG8_WAIT_L(0); PG8_MMA(1, 0, At, B0); PG8_BAR; PG8_SCHED;
            PG8_STAGE(PG8_SB(0, 1), b2 + hstep, voffB);
            PG8_WAIT_V(6); PG8_BAR; PG8_MMA(1, 1, At, B1); PG8_BAR;
            PG8_LDB(B0, 1, 0); PG8_SCHED; PG8_LDA(At, 1, 0); PG8_STAGE(PG8_SA(0, 1), a2 + hstep, voffA);
            PG8_WAIT_L(8); PG8_BAR; PG8_WAIT_L(0); PG8_MMA(0, 0, At, B0); PG8_BAR; PG8_SCHED;
            PG8_LDB(B1, 1, 1); PG8_STAGE(PG8_SB(1, 0), b3, voffB);
            PG8_BAR; PG8_WAIT_L(0); PG8_MMA(0, 1, At, B1); PG8_BAR;
            PG8_LDA(At, 1, 1); PG8_STAGE(PG8_SA(1, 0), a3, voffA);
            PG8_BAR; PG8_WAIT_L(0); PG8_MMA(1, 0, At, B0); PG8_BAR; PG8_SCHED;
            PG8_STAGE(PG8_SB(1, 1), b3 + hstep, voffB);
            PG8_WAIT_V(6); PG8_BAR; PG8_MMA(1, 1, At, B1); PG8_BAR;
            }
        }
        if constexpr (ALIGN_EPI) { if (wr == 0) PG8_BAR; }
        if constexpr (!Epi::AFTER_DRAIN) { E(acc, cur, ui, wr, wc, fr, fq); S.done(cur); }
        if (!has_next) break;
#pragma unroll
        for (int a = 0; a < 2; ++a)
#pragma unroll
            for (int b = 0; b < 2; ++b)
#pragma unroll
                for (int m = 0; m < 4; ++m)
#pragma unroll
                    for (int n = 0; n < 2; ++n) acc[a][b][m][n] = (f32x4){0.f, 0.f, 0.f, 0.f};
        cur = nxt; cA = nA; cB = nB; ++ui;
        if constexpr (ALIGN_EPI) { if (wr == 1) PG8_BAR; }
    }
    PG8_WAIT_V(0);
    if constexpr (!ALIGN_EPI) { if (wr == 0) PG8_BAR; }
    PG8_BAR;
#undef PG8_SA
#undef PG8_SB
#undef PG8_STAGE
#undef PG8_LDA
#undef PG8_LDB
#undef PG8_MMA
#undef PG8_WAIT_V
#undef PG8_WAIT_L
#undef PG8_BAR
#undef PG8_SCHED
}
}

#define LAS __attribute__((address_space(3)))
typedef unsigned short bf16;
typedef unsigned v4u __attribute__((ext_vector_type(4)));
typedef unsigned v2u __attribute__((ext_vector_type(2)));
typedef float f32x4 __attribute__((ext_vector_type(4)));
typedef float f32x2v __attribute__((ext_vector_type(2)));
typedef short bf16x8 __attribute__((ext_vector_type(8)));

constexpr int NWAVES = 8;
constexpr int M = 8192, D = 4096, DIN = 8192, DA = 2048, DFF = 11008, SEQ = 2048;
constexpr float EPS = 1e-6f, LOG2E = 1.4426950408889634f;
constexpr size_t MiB = 1u << 20;
constexpr size_t WS_WIN = 0, WS_WOUT = 64 * MiB, WS_WFI = 96 * MiB, WS_WFO = 268 * MiB, WS_XN = 354 * MiB, WS_PROJ = 418 * MiB, WS_Y = 546 * MiB,
                 WS_HL = 610 * MiB, WS_PC = 674 * MiB, WS_O1 = 738 * MiB, WS_ACT = 802 * MiB, WS_SSA = 974 * MiB, WS_SSB = WS_SSA + 512 * 1024,
                 WS_SS1 = 975 * MiB, WS_SS2 = 977 * MiB, WS_AGGP = 979 * MiB, WS_AGGH = 980 * MiB, WS_SP = 981 * MiB, WS_CTL = 982 * MiB, WS_END = 983 * MiB;
constexpr size_t CTL_ZERO_BYTES = 65536;
constexpr int RING_BYTES = 131072, RSL_OFF = RING_BYTES, MISC_OFF = RING_BYTES + 16384, LDS_BYTES = MISC_OFF + 256;

#define LDS_WAIT() asm volatile("s_waitcnt lgkmcnt(0)" ::: "memory")
__device__ __forceinline__ unsigned cvtpk(float lo, float hi) { return pg8::cvt_pk_bf16(lo, hi); }
__device__ __forceinline__ float bflo(unsigned w) { return __builtin_bit_cast(float, w << 16); }
__device__ __forceinline__ float bfhi(unsigned w) { return __builtin_bit_cast(float, w & 0xffff0000u); }
__device__ __forceinline__ float wave_sum(float v) {
#pragma unroll
    for (int o = 1; o < 64; o <<= 1) v += __shfl_xor(v, o);
    return v;
}
__device__ __forceinline__ float fexp2(float x) { return __builtin_amdgcn_exp2f(x); }
__device__ __forceinline__ float frcp(float x) { return __builtin_amdgcn_rcpf(x); }
__device__ __forceinline__ float gelu_tanh(float x) { const float z = x * (1.0f + 0.044715f * x * x); return x * frcp(1.0f + fexp2(-2.302208198f * z)); }
__device__ __forceinline__ float sigmoidf_(float x) { return frcp(1.0f + fexp2(-LOG2E * x)); }
template <int CTRL> __device__ __forceinline__ float dpp_f(float old, float src) {
    return __builtin_bit_cast(float, __builtin_amdgcn_update_dpp(__builtin_bit_cast(int, old), __builtin_bit_cast(int, src), CTRL, 0xf, 0xf, false));
}

namespace pg8 {
struct EpiProj {
    static constexpr bool PERM = true, AFTER_DRAIN = false, MID = false;
    bf16_t* O;
    __device__ __forceinline__ void mid(f32x4 (&)[2][2][4][2], int, int, int) const {}
    __device__ __forceinline__ void operator()(const f32x4 (&acc)[2][2][4][2], const Unit& u, int ui, int wr, int wc, int fr, int fq) const {
        const bool act = u.pn < 24;
        const int row0 = u.pm * BM + wr * 64 + fr, col0 = u.pn * BM + wc * 32 + 8 * fq;
#pragma unroll
        for (int ai = 0; ai < 2; ++ai)
#pragma unroll
            for (int m = 0; m < 4; ++m) { bf16_t* rowp = O + (size_t)(row0 + ai * HALF + m * 16) * DIN + col0;
#pragma unroll
                for (int bj = 0; bj < 2; ++bj) { f32x4 v0 = acc[ai][bj][m][0], v1 = acc[ai][bj][m][1];
                    if (act) {
#pragma unroll
                        for (int j = 0; j < 4; ++j) { v0[j] = gelu_tanh(v0[j]); v1[j] = gelu_tanh(v1[j]); } }
                    u32x4 w; w.x = cvt_pk_bf16(v0[0], v0[1]); w.y = cvt_pk_bf16(v0[2], v0[3]); w.z = cvt_pk_bf16(v1[0], v1[1]); w.w = cvt_pk_bf16(v1[2], v1[3]);
                    *(u32x4*)(rowp + bj * HALF) = w; } }
    }
};
template <bool SCALE> struct EpiRows {
    static constexpr bool PERM = true, AFTER_DRAIN = false, MID = SCALE;
    bf16_t* O; float* SS; PG8_LAS unsigned char* rsl;
    __device__ __forceinline__ void mid(f32x4 (&acc)[2][2][4][2], int ui, int wr, int fr) const {
        typedef float f2 __attribute__((ext_vector_type(2)));
#pragma unroll
        for (int ai = 0; ai < 2; ++ai)
#pragma unroll
            for (int m = 0; m < 4; ++m) { const int rl = ai * HALF + wr * 64 + m * 16 + fr; const f2 s = *(const PG8_LAS f2*)(rsl + (size_t)(ui * 256 + rl) * 8);
#pragma unroll
                for (int bj = 0; bj < 2; ++bj)
#pragma unroll
                    for (int n = 0; n < 2; ++n) acc[ai][bj][m][n] = acc[ai][bj][m][n] * s.x; }
    }
    __device__ __forceinline__ void operator()(const f32x4 (&acc)[2][2][4][2], const Unit& u, int ui, int wr, int wc, int fr, int fq) const {
        typedef float f2 __attribute__((ext_vector_type(2)));
        const int row0 = u.pm * BM + wr * 64 + fr, col0 = u.pn * BM + wc * 32 + 8 * fq;
#pragma unroll
        for (int ai = 0; ai < 2; ++ai)
#pragma unroll
            for (int m = 0; m < 4; ++m) { const int rl = ai * HALF + wr * 64 + m * 16 + fr; const int row = u.pm * BM + rl;
                float sc = 1.0f; if (SCALE) { const f2 s = *(const PG8_LAS f2*)(rsl + (size_t)(ui * 256 + rl) * 8); sc = s.y; }
                bf16_t* rowp = O + (size_t)row * 4096 + col0; float ss = 0.f;
#pragma unroll
                for (int bj = 0; bj < 2; ++bj) { const f32x4 v0 = acc[ai][bj][m][0] * sc, v1 = acc[ai][bj][m][1] * sc;
                    ss += (v0[0] * v0[0] + v0[1] * v0[1]) + (v0[2] * v0[2] + v0[3] * v0[3]) + (v1[0] * v1[0] + v1[1] * v1[1]) + (v1[2] * v1[2] + v1[3] * v1[3]);
                    u32x4 w; w.x = cvt_pk_bf16(v0[0], v0[1]); w.y = cvt_pk_bf16(v0[2], v0[3]); w.z = cvt_pk_bf16(v1[0], v1[1]); w.w = cvt_pk_bf16(v1[2], v1[3]);
                    *(u32x4*)(rowp + bj * HALF) = w; }
                ss += __shfl_xor(ss, 16); ss += __shfl_xor(ss, 32);
                if (fq == 0) SS[(size_t)row * 64 + u.pn * 4 + wc] = ss; }
    }
};
struct EpiSwiGLU {
    static constexpr bool PERM = true, AFTER_DRAIN = false, MID = false;
    bf16_t* O;
    __device__ __forceinline__ void mid(f32x4 (&)[2][2][4][2], int, int, int) const {}
    __device__ __forceinline__ void operator()(const f32x4 (&acc)[2][2][4][2], const Unit& u, int ui, int wr, int wc, int fr, int fq) const {
        const int row0 = u.pm * BM + wr * 64 + fr, col0 = u.pn * HALF + wc * 32 + 8 * fq;
#pragma unroll
        for (int ai = 0; ai < 2; ++ai)
#pragma unroll
            for (int m = 0; m < 4; ++m) { bf16_t* rowp = O + (size_t)(row0 + ai * HALF + m * 16) * 11008 + col0;
                f32x4 v0, v1;
#pragma unroll
                for (int j = 0; j < 4; ++j) { const float g0 = acc[ai][0][m][0][j], g1 = acc[ai][0][m][1][j];
                    v0[j] = g0 * __builtin_amdgcn_rcpf(1.0f + __builtin_amdgcn_exp2f(-1.4426950408889634f * g0)) * acc[ai][1][m][0][j];
                    v1[j] = g1 * __builtin_amdgcn_rcpf(1.0f + __builtin_amdgcn_exp2f(-1.4426950408889634f * g1)) * acc[ai][1][m][1][j]; }
                u32x4 w; w.x = cvt_pk_bf16(v0[0], v0[1]); w.y = cvt_pk_bf16(v0[2], v0[3]); w.z = cvt_pk_bf16(v1[0], v1[1]); w.w = cvt_pk_bf16(v1[2], v1[3]);
                *(u32x4*)rowp = w; }
    }
};
}

__device__ __forceinline__ void p0_load_item(f32x4 (&v)[16], const float* src, size_t N, int lane) {
    const float* p = src + (size_t)(lane >> 4) * N + 4 * (lane & 15);
#pragma unroll
    for (int i = 0; i < 16; ++i) v[i] = __builtin_nontemporal_load((const f32x4*)(p + (size_t)(4 * i) * N));
}
template <bool NT> __device__ __forceinline__ void p0_store_item(const f32x4 (&v)[16], bf16* dst, size_t K, LAS float* scr, int lane) {
    const int r = lane >> 4, c = lane & 15;
#pragma unroll
    for (int i = 0; i < 16; ++i) { LAS float* s = scr + (4 * i + r) * 65 + 4 * c; s[0] = v[i].x; s[1] = v[i].y; s[2] = v[i].z; s[3] = v[i].w; }
    LDS_WAIT(); asm volatile("" ::: "memory");
    const int c8 = lane & 7;
#pragma unroll
    for (int j = 0; j < 8; ++j) { const int n = (lane >> 3) + 8 * j; const LAS float* s = scr + (8 * c8) * 65 + n;
        v4u o; o.x = cvtpk(s[0 * 65], s[1 * 65]); o.y = cvtpk(s[2 * 65], s[3 * 65]); o.z = cvtpk(s[4 * 65], s[5 * 65]); o.w = cvtpk(s[6 * 65], s[7 * 65]);
        if (NT) __builtin_nontemporal_store(o, (v4u*)(dst + (size_t)n * K + 8 * c8)); else *(v4u*)(dst + (size_t)n * K + 8 * c8) = o; }
    LDS_WAIT(); asm volatile("" ::: "memory");
}
__device__ __forceinline__ void rms_row_to_bf16(const float* xrow, const float* g, bf16* orow, int lane) {
    const f32x4* xr = (const f32x4*)xrow + lane;
    f32x4 v[16]; float s = 0.f;
#pragma unroll
    for (int j = 0; j < 16; ++j) { v[j] = __builtin_nontemporal_load(xr + 64 * j); s += (v[j].x * v[j].x + v[j].y * v[j].y) + (v[j].z * v[j].z + v[j].w * v[j].w); }
    const float rs = 1.0f / sqrtf(wave_sum(s) * (1.0f / D) + EPS);
    v2u* o8 = (v2u*)orow + lane; const f32x4* gp = (const f32x4*)g + lane;
#pragma unroll
    for (int j = 0; j < 16; ++j) { const f32x4 gg = gp[64 * j]; v2u o; o.x = cvtpk(v[j].x * rs * gg.x, v[j].y * rs * gg.y); o.y = cvtpk(v[j].z * rs * gg.z, v[j].w * rs * gg.w); o8[64 * j] = o; }
}

__device__ __forceinline__ void gmlp_unit(LAS unsigned char* lds, int unit, const bf16* PROJ, const float* WSP, const float* BSP, const float* GV, const float* GOA, bf16* Y, float* SSA) {
    const int tid = threadIdx.x, lane = tid & 63, w = __builtin_amdgcn_readfirstlane(tid >> 6), c16 = lane & 15, q = lane >> 4;
    const int h = unit & 15, tok0 = (unit >> 4) * 128;
    LAS bf16* VT = (LAS bf16*)lds;
    const int trow = 16 * w + c16, nks = (16 * w + 15) / 32 + 1;
    f32x4 wq[4][2];
#pragma unroll
    for (int ks = 0; ks < 4; ++ks) { wq[ks][0] = (f32x4){0.f, 0.f, 0.f, 0.f}; wq[ks][1] = wq[ks][0];
        if (ks < nks) { const float* wp = WSP + ((size_t)h * 128 + trow) * 128 + 32 * ks + 8 * q; wq[ks][0] = *(const f32x4*)wp; wq[ks][1] = *(const f32x4*)(wp + 4); } }
    v2u uq[8];
#pragma unroll
    for (int db = 0; db < 8; ++db) uq[db] = *(const v2u*)(PROJ + (size_t)(tok0 + 16 * w + c16) * DIN + h * 128 + 16 * db + 4 * q);
    {   const int c = tid & 15;
#pragma unroll
        for (int i = 0; i < 4; ++i) { const int s = (tid >> 4) + 32 * i;
            const v4u raw = *(const v4u*)(PROJ + (size_t)(tok0 + s) * DIN + 2048 + h * 128 + 8 * c);
            float f[8]; f[0] = bflo(raw.x); f[1] = bfhi(raw.x); f[2] = bflo(raw.y); f[3] = bfhi(raw.y); f[4] = bflo(raw.z); f[5] = bfhi(raw.z); f[6] = bflo(raw.w); f[7] = bfhi(raw.w);
            float ss = 0.f;
#pragma unroll
            for (int k = 0; k < 8; ++k) ss += f[k] * f[k];
            ss += __shfl_xor(ss, 1); ss += __shfl_xor(ss, 2); ss += __shfl_xor(ss, 4); ss += __shfl_xor(ss, 8);
            const float rs = 1.0f / sqrtf(ss * (1.0f / 128.0f) + EPS);
#pragma unroll
            for (int k = 0; k < 4; ++k) { const unsigned pk = cvtpk(f[2 * k] * rs, f[2 * k + 1] * rs);
                const int sp_ = (((s >> 3) ^ c) << 3) | (s & 7);
                VT[(8 * c + 2 * k) * 136 + sp_] = (bf16)(pk & 0xffffu); VT[(8 * c + 2 * k + 1) * 136 + sp_] = (bf16)(pk >> 16); } }
    }
    __syncthreads();
    f32x4 acc[8];
#pragma unroll
    for (int db = 0; db < 8; ++db) acc[db] = (f32x4){0.f, 0.f, 0.f, 0.f};
#pragma unroll
    for (int ks = 0; ks < 4; ++ks) if (ks < nks) {
        const f32x4 w0 = wq[ks][0], w1 = wq[ks][1];
        const int sb = 32 * ks + 8 * q;
        float wv[8] = {w0.x, w0.y, w0.z, w0.w, w1.x, w1.y, w1.z, w1.w};
#pragma unroll
        for (int j = 0; j < 8; ++j) wv[j] = (sb + j <= trow) ? wv[j] : 0.f;
        v4u wpk; wpk.x = cvtpk(wv[0], wv[1]); wpk.y = cvtpk(wv[2], wv[3]); wpk.z = cvtpk(wv[4], wv[5]); wpk.w = cvtpk(wv[6], wv[7]);
        const bf16x8 wf = __builtin_bit_cast(bf16x8, wpk);
#pragma unroll
        for (int db = 0; db < 8; ++db) { const bf16x8 vf = *(const LAS bf16x8*)(VT + (16 * db + c16) * 136 + (((4 * ks + q) ^ ((16 * db + c16) >> 3)) << 3));
            acc[db] = __builtin_amdgcn_mfma_f32_16x16x32_bf16(vf, wf, acc[db], 0, 0, 0); }
    }
    const int tok = tok0 + 16 * w + c16; const float bsp = BSP[h * 128 + 16 * w + c16]; float ssq = 0.f;
#pragma unroll
    for (int db = 0; db < 8; ++db) { const int dcol = h * 128 + 16 * db + 4 * q;
        const v2u ur = uq[db]; const f32x4 g = *(const f32x4*)(GV + dcol);
        const float y0 = bflo(ur.x) * (g.x * acc[db][0] + bsp), y1 = bfhi(ur.x) * (g.y * acc[db][1] + bsp), y2 = bflo(ur.y) * (g.z * acc[db][2] + bsp), y3 = bfhi(ur.y) * (g.w * acc[db][3] + bsp);
        ssq += (y0 * y0 + y1 * y1) + (y2 * y2 + y3 * y3);
        const f32x4 go = *(const f32x4*)(GOA + dcol); v2u o; o.x = cvtpk(y0 * go.x, y1 * go.y); o.y = cvtpk(y2 * go.z, y3 * go.w); *(v2u*)(Y + (size_t)tok * D + dcol) = o; }
    ssq += __shfl_xor(ssq, 16); ssq += __shfl_xor(ssq, 32);
    if (q == 0) SSA[(size_t)tok * 16 + h] = ssq;
    __syncthreads();
}

__device__ __forceinline__ void rglru_local_unit(LAS unsigned char* lds, int unit, const bf16* PROJ, const float* WR, const float* WI, const float* BR, const float* BI,
                                                 const float* WCONV, const float* BCONV, const float* SP, float* HL, float* PC, float* AGGP, float* AGGH) {
    const int tid = threadIdx.x, lane = tid & 63, w = __builtin_amdgcn_readfirstlane(tid >> 6), c16 = lane & 15, q = lane >> 4;
    const int n = unit & 15, tg = unit >> 4;
#pragma unroll 2
    for (int i = 0; i < 8; ++i) {
        const int f = tid + 512 * i, l2 = f & 63, ks = (f >> 6) & 3, eb = (f >> 8) & 7, mat = f >> 11, i2 = l2 & 15, q2 = l2 >> 4;
        const int e = 32 * (eb >> 1) + 8 * (i2 >> 2) + 4 * (eb & 1) + (i2 & 3);
        const float* src = (mat ? WI : WR) + ((size_t)n * 128 + 32 * ks + 8 * q2) * 128 + e;
        v4u o; o.x = cvtpk(src[0], src[128]); o.y = cvtpk(src[256], src[384]); o.z = cvtpk(src[512], src[640]); o.w = cvtpk(src[768], src[896]);
        *(LAS v4u*)(lds + (size_t)f * 16) = o;
    }
    __syncthreads();
    const int token0 = tg * 512 + w * 64, gc = token0 >> 6;
    LAS f32x2v* cst = (LAS f32x2v*)(lds + 65536 + w * 1024) + q * 32;
#pragma unroll
    for (int i = 0; i < 32; ++i) if (c16 == 15) cst[i] = (f32x2v){1.0f, 0.0f};
#pragma unroll 1
    for (int tb = 0; tb < 4; ++tb) {
        const int tok = token0 + 16 * tb + c16, s = tok & (SEQ - 1);
        int zo = 0; asm volatile("" : "+v"(zo));
        const float* BCONV_ = BCONV + zo; const float* WCONV_ = WCONV + zo; const float* BR_ = BR + zo; const float* BI_ = BI + zo; const float* SP_ = SP + zo;
        float xc[4][8]; bf16x8 xf[4];
#pragma unroll
        for (int ks = 0; ks < 4; ++ks) {
            const int ch0 = n * 128 + 32 * ks + 8 * q;
            const f32x4 b0 = *(const f32x4*)(BCONV_ + ch0), b1 = *(const f32x4*)(BCONV_ + ch0 + 4);
            float a[8] = {b0.x, b0.y, b0.z, b0.w, b1.x, b1.y, b1.z, b1.w};
#pragma unroll
            for (int k = 0; k < 4; ++k) {
                v4u raw = (v4u){0u, 0u, 0u, 0u};
                if (s - 3 + k >= 0) raw = *(const v4u*)(PROJ + (size_t)(tok - 3 + k) * DIN + 6144 + ch0);
                const f32x4 w0 = *(const f32x4*)(WCONV_ + k * 2048 + ch0), w1 = *(const f32x4*)(WCONV_ + k * 2048 + ch0 + 4);
                a[0] += w0.x * bflo(raw.x); a[1] += w0.y * bfhi(raw.x); a[2] += w0.z * bflo(raw.y); a[3] += w0.w * bfhi(raw.y);
                a[4] += w1.x * bflo(raw.z); a[5] += w1.y * bfhi(raw.z); a[6] += w1.z * bflo(raw.w); a[7] += w1.w * bfhi(raw.w);
            }
#pragma unroll
            for (int j = 0; j < 8; ++j) xc[ks][j] = a[j];
            v4u pk; pk.x = cvtpk(a[0], a[1]); pk.y = cvtpk(a[2], a[3]); pk.z = cvtpk(a[4], a[5]); pk.w = cvtpk(a[6], a[7]);
            xf[ks] = __builtin_bit_cast(bf16x8, pk);
        }
#pragma unroll
        for (int ebh = 0; ebh < 2; ++ebh) {
            f32x4 ar[4], ai[4];
#pragma unroll
            for (int e4 = 0; e4 < 4; ++e4) { ar[e4] = (f32x4){0.f, 0.f, 0.f, 0.f}; ai[e4] = (f32x4){0.f, 0.f, 0.f, 0.f}; }
#pragma unroll
            for (int e4 = 0; e4 < 4; ++e4)
#pragma unroll
                for (int ks = 0; ks < 4; ++ks) { const int eb = 4 * ebh + e4;
                    const bf16x8 wfr = *(const LAS bf16x8*)(lds + (size_t)(((0 * 8 + eb) * 4 + ks) * 64 + lane) * 16);
                    const bf16x8 wfi = *(const LAS bf16x8*)(lds + (size_t)(((1 * 8 + eb) * 4 + ks) * 64 + lane) * 16);
                    ar[e4] = __builtin_amdgcn_mfma_f32_16x16x32_bf16(wfr, xf[ks], ar[e4], 0, 0, 0);
                    ai[e4] = __builtin_amdgcn_mfma_f32_16x16x32_bf16(wfi, xf[ks], ai[e4], 0, 0, 0); }
#pragma unroll
            for (int e4 = 0; e4 < 4; ++e4) { const int eb = 4 * ebh + e4, ksx = eb >> 1, jj0 = 4 * (eb & 1), ch = n * 128 + 32 * ksx + 8 * q + jj0;
                const f32x4 br = *(const f32x4*)(BR_ + ch), bi = *(const f32x4*)(BI_ + ch), sp = *(const f32x4*)(SP_ + ch);
                f32x4 hv, pv;
#pragma unroll
                for (int j = 0; j < 4; ++j) {
                    const float r = sigmoidf_(ar[e4][j] + br[j]), ig = sigmoidf_(ai[e4][j] + bi[j]);
                    const float la = -8.0f * r * sp[j];
                    float a = fexp2(la * LOG2E);
                    const float x2 = 2.0f * la;
                    float pm = 1.0f / 720.0f; pm = pm * x2 + 1.0f / 120.0f; pm = pm * x2 + 1.0f / 24.0f; pm = pm * x2 + 1.0f / 6.0f; pm = pm * x2 + 0.5f; pm = pm * x2 + 1.0f; pm = pm * x2;
                    const float m2 = (x2 > -0.25f) ? -pm : (1.0f - a * a);
                    float b = sqrtf(fmaxf(m2, 1e-12f)) * (ig * xc[ksx][jj0 + j]);
                    { const float ap = dpp_f<0x111>(1.0f, a), bp = dpp_f<0x111>(0.0f, b); b = a * bp + b; a = a * ap; }
                    { const float ap = dpp_f<0x112>(1.0f, a), bp = dpp_f<0x112>(0.0f, b); b = a * bp + b; a = a * ap; }
                    { const float ap = dpp_f<0x114>(1.0f, a), bp = dpp_f<0x114>(0.0f, b); b = a * bp + b; a = a * ap; }
                    { const float ap = dpp_f<0x118>(1.0f, a), bp = dpp_f<0x118>(0.0f, b); b = a * bp + b; a = a * ap; }
                    const int ci = eb * 4 + j;
                    const f32x2v cr = cst[ci];
                    const float P = a * cr.x, H = b + a * cr.y;
                    pv[j] = P; hv[j] = H;
                    if (c16 == 15) cst[ci] = (f32x2v){P, H};
                }
                const size_t di = ((((size_t)gc * 16 + n) * 4 + tb) * 8 + eb) * 64 + lane;
                { v4u o; o.x = cvtpk(hv[0], hv[1]); o.y = cvtpk(hv[2], hv[3]); o.z = cvtpk(pv[0], pv[1]); o.w = cvtpk(pv[2], pv[3]); __builtin_nontemporal_store(o, (v4u*)HL + di); }
                if (tb == 3 && c16 == 15) { *(f32x4*)(AGGP + (size_t)gc * 2048 + ch) = pv; *(f32x4*)(AGGH + (size_t)gc * 2048 + ch) = hv; }
            }
        }
    }
    __syncthreads();
}

__device__ __forceinline__ void rglru_final_unit(int unit, const bf16* PROJ, const float* HL, const float* PC, const float* AGGP, const float* AGGH, const float* GOB, bf16* Y, float* SSB) {
    const int tid = threadIdx.x, lane = tid & 63, w = __builtin_amdgcn_readfirstlane(tid >> 6), c16 = lane & 15, q = lane >> 4;
    const int n = unit & 15, tg = unit >> 4;
    const int token0 = tg * 512 + w * 64, gc = token0 >> 6, cin = gc & 31, gb = gc - cin;
    float carry[32];
#pragma unroll
    for (int eb = 0; eb < 8; ++eb) { const int ch = n * 128 + 32 * (eb >> 1) + 8 * q + 4 * (eb & 1);
        f32x4 p0 = (f32x4){1.f, 1.f, 1.f, 1.f}, h0 = (f32x4){0.f, 0.f, 0.f, 0.f}, p1 = p0, h1 = h0;
        if (2 * c16 < cin) { p0 = *(const f32x4*)(AGGP + (size_t)(gb + 2 * c16) * 2048 + ch); h0 = *(const f32x4*)(AGGH + (size_t)(gb + 2 * c16) * 2048 + ch); }
        if (2 * c16 + 1 < cin) { p1 = *(const f32x4*)(AGGP + (size_t)(gb + 2 * c16 + 1) * 2048 + ch); h1 = *(const f32x4*)(AGGH + (size_t)(gb + 2 * c16 + 1) * 2048 + ch); }
#pragma unroll
        for (int j = 0; j < 4; ++j) {
            float a = p0[j] * p1[j], b = p1[j] * h0[j] + h1[j];
            { float ap = dpp_f<0x111>(1.0f, a), bp = dpp_f<0x111>(0.0f, b); ap = (c16 >= 1) ? ap : 1.0f; bp = (c16 >= 1) ? bp : 0.0f; b = a * bp + b; a = a * ap; }
            { float ap = dpp_f<0x112>(1.0f, a), bp = dpp_f<0x112>(0.0f, b); ap = (c16 >= 2) ? ap : 1.0f; bp = (c16 >= 2) ? bp : 0.0f; b = a * bp + b; a = a * ap; }
            { float ap = dpp_f<0x114>(1.0f, a), bp = dpp_f<0x114>(0.0f, b); ap = (c16 >= 4) ? ap : 1.0f; bp = (c16 >= 4) ? bp : 0.0f; b = a * bp + b; a = a * ap; }
            { float ap = dpp_f<0x118>(1.0f, a), bp = dpp_f<0x118>(0.0f, b); ap = (c16 >= 8) ? ap : 1.0f; bp = (c16 >= 8) ? bp : 0.0f; b = a * bp + b; a = a * ap; }
            carry[4 * eb + j] = __shfl(b, (lane & 48) | 15);
        }
    }
#pragma unroll 1
    for (int tb = 0; tb < 4; ++tb) {
        const int tok = token0 + 16 * tb + c16; float ssq = 0.f;
#pragma unroll
        for (int eb = 0; eb < 8; ++eb) { const int chl = 32 * (eb >> 1) + 8 * q + 4 * (eb & 1);
            const size_t di = ((((size_t)gc * 16 + n) * 4 + tb) * 8 + eb) * 64 + lane;
            const v4u hp = __builtin_nontemporal_load((const v4u*)HL + di); const f32x4 hv = (f32x4){bflo(hp.x), bfhi(hp.x), bflo(hp.y), bfhi(hp.y)}, pv = (f32x4){bflo(hp.z), bfhi(hp.z), bflo(hp.w), bfhi(hp.w)};
            const v2u gr = *(const v2u*)(PROJ + (size_t)tok * DIN + 4096 + n * 128 + chl);
            const float y0 = (hv[0] + pv[0] * carry[4 * eb + 0]) * bflo(gr.x), y1 = (hv[1] + pv[1] * carry[4 * eb + 1]) * bfhi(gr.x),
                        y2 = (hv[2] + pv[2] * carry[4 * eb + 2]) * bflo(gr.y), y3 = (hv[3] + pv[3] * carry[4 * eb + 3]) * bfhi(gr.y);
            ssq += (y0 * y0 + y1 * y1) + (y2 * y2 + y3 * y3);
            const f32x4 go = *(const f32x4*)(GOB + n * 128 + chl); v2u o; o.x = cvtpk(y0 * go.x, y1 * go.y); o.y = cvtpk(y2 * go.z, y3 * go.w); *(v2u*)(Y + (size_t)tok * D + 2048 + n * 128 + chl) = o; }
        ssq += __shfl_xor(ssq, 16); ssq += __shfl_xor(ssq, 32);
        if (q == 0) SSB[(size_t)tok * 16 + n] = ssq;
    }
}

#define XB_TMO      128
#define XB_XCNT(j)  (256  + 64 * (j))
#define XB_XSUB(j)  (1280 + 64 * (j))
#define XB_XGEN(j)  (2304 + 64 * (j))
#define XB_TOP      3328
#define XB_TOPGEN   3392
#define XCD_BAR_WORDS 3456
#define XB_SPIN_CAP (1u << 18)

__device__ __forceinline__ unsigned xb_ld(unsigned* p)              { return __hip_atomic_load(p, __ATOMIC_RELAXED, __HIP_MEMORY_SCOPE_AGENT); }
__device__ __forceinline__ unsigned xb_add(unsigned* p, unsigned v) { return __hip_atomic_fetch_add(p, v, __ATOMIC_RELAXED, __HIP_MEMORY_SCOPE_AGENT); }
__device__ __forceinline__ unsigned xb_xcc_id() { return (unsigned)__builtin_amdgcn_s_getreg((3 << 11) | 20) & 0xFu; }
#define XB_SPIN(cond, bar) do { unsigned _sp = 0; while (cond) { __builtin_amdgcn_s_sleep(1); \
    if ((++_sp & 255u) == 0u) { if (xb_ld(&(bar)[XB_TMO])) break; if (_sp > XB_SPIN_CAP) { atomicAdd(&(bar)[XB_TMO], 1u); break; } } } } while (0)

struct XcdBarrier {
    unsigned* bar; unsigned x;
    volatile LAS unsigned* st;
};

__device__ __forceinline__ XcdBarrier xcd_barrier_post(unsigned* bar, volatile LAS unsigned* st) {
    XcdBarrier b; b.bar = bar; b.x = xb_xcc_id(); b.st = st;
    if (threadIdx.x == 0) (void)xb_add(&bar[XB_XCNT(b.x)], 1u);
    return b;
}
__device__ __forceinline__ void xcd_barrier_complete(unsigned* bar, unsigned x, unsigned& nloc, unsigned& nx) {
    const unsigned G = gridDim.x * gridDim.y * gridDim.z;
    unsigned sum, cnt, mine, sp = 0u;
    for (;;) {
        sum = 0u; cnt = 0u; mine = 0u;
#pragma unroll
        for (unsigned j = 0; j < 16; ++j) { const unsigned c = xb_ld(&bar[XB_XCNT(j)]); sum += c; cnt += (c > 0u) ? 1u : 0u; mine = (j == x) ? c : mine; }
        if (sum == G) break;
        __builtin_amdgcn_s_sleep(1);
        if ((++sp & 255u) == 0u) { if (xb_ld(&bar[XB_TMO])) break; if (sp > XB_SPIN_CAP) { atomicAdd(&bar[XB_TMO], 1u); break; } }
    }
    nloc = mine > 0u ? mine : 1u; nx = cnt > 0u ? cnt : 1u;
}

__device__ __forceinline__ void xcd_barrier(const XcdBarrier& b) {
    asm volatile("s_waitcnt vmcnt(0)" ::: "memory");
    __syncthreads();
    if (threadIdx.x == 0) {
        unsigned* bar = b.bar;
        __builtin_amdgcn_s_waitcnt(0);
        unsigned nloc = b.st[0], nx = b.st[1];
        if (nloc == 0u) { xcd_barrier_complete(bar, b.x, nloc, nx); b.st[0] = nloc; b.st[1] = nx; }
        const unsigned old = xb_add(&bar[XB_XSUB(b.x)], 1u);
        const unsigned gen = old / nloc;
        if (old + 1u == (gen + 1u) * nloc) {
            __builtin_amdgcn_fence(__ATOMIC_RELEASE, "agent");
            asm volatile("s_waitcnt vmcnt(0)" ::: "memory");
            const unsigned og = xb_add(&bar[XB_TOP], 1u);
            const unsigned tg = og / nx;
            if (og + 1u == (tg + 1u) * nx) xb_add(&bar[XB_TOPGEN], 1u);
            else XB_SPIN(xb_ld(&bar[XB_TOPGEN]) == tg, bar);
            __builtin_amdgcn_fence(__ATOMIC_ACQUIRE, "agent");
            xb_add(&bar[XB_XGEN(b.x)], 1u);
            asm volatile("s_waitcnt vmcnt(0)" ::: "memory");
        } else {
            XB_SPIN(xb_ld(&bar[XB_XGEN(b.x)]) == gen, bar);
            __builtin_amdgcn_fence(__ATOMIC_ACQUIRE, "agent");
            asm volatile("s_waitcnt vmcnt(0)" ::: "memory");
        }
    }
    __syncthreads();
}

struct Args { const float* in[21]; float* out; unsigned char* ws; int ph_lo, ph_hi; };
constexpr int N_PHASES = 9;

__global__ void __launch_bounds__(NWAVES * 64, 2) mk_fwd(Args args) {
    extern __shared__ __attribute__((aligned(16))) unsigned char lds_raw[];
    LAS unsigned char* lds = (LAS unsigned char*)lds_raw;
    const int tid = threadIdx.x, lane = tid & 63, wave = __builtin_amdgcn_readfirstlane(tid >> 6);
    const int G = gridDim.x, bx = blockIdx.x, gw = bx * NWAVES + wave, NGW = G * NWAVES;
    unsigned char* ws = args.ws;
    const float* x = args.in[0]; float* out = args.out;
    bf16* WinT = (bf16*)(ws + WS_WIN); bf16* WoutT = (bf16*)(ws + WS_WOUT); bf16* WfiT = (bf16*)(ws + WS_WFI); bf16* WfoT = (bf16*)(ws + WS_WFO);
    bf16* XN = (bf16*)(ws + WS_XN); bf16* PROJ = (bf16*)(ws + WS_PROJ); bf16* Y = (bf16*)(ws + WS_Y); bf16* O1 = (bf16*)(ws + WS_O1); bf16* ACT = (bf16*)(ws + WS_ACT);
    float* HL = (float*)(ws + WS_HL); float* PC = (float*)(ws + WS_PC); bf16* FB = (bf16*)(ws + WS_PC); float* SSA = (float*)(ws + WS_SSA); float* SSB = (float*)(ws + WS_SSB);
    float* SS1 = (float*)(ws + WS_SS1); float* SS2 = (float*)(ws + WS_SS2); float* AGGP = (float*)(ws + WS_AGGP); float* AGGH = (float*)(ws + WS_AGGH); float* SP = (float*)(ws + WS_SP);
    const int lo = args.ph_lo, hi = args.ph_hi;
    if (hi > 1000) cg::this_grid().sync();
    volatile LAS unsigned* MISC = (volatile LAS unsigned*)(lds + MISC_OFF);
    if (tid < 64) MISC[tid] = 0u;
    __syncthreads();
    XcdBarrier bar; bar.bar = (unsigned*)(ws + WS_CTL); bar.x = 0; bar.st = nullptr;
    if (hi - lo > 1) bar = xcd_barrier_post((unsigned*)(ws + WS_CTL), MISC);
#ifndef PH_MASK
#define PH_MASK 0x1ff
#endif
#define IN(k) (((PH_MASK >> (k)) & 1) && lo <= (k) && (k) < hi)
#ifndef PROBE_DUP
#define PROBE_DUP 0
#endif
#ifndef PROBE_SYNC
#define PROBE_SYNC 1
#endif
#define NREP(k) (1 + ((PROBE_DUP >> (k)) & 1))
#define SEAM(k) do { if (IN(k) && IN((k) + 1)) { for (int r_ = 0; r_ < PROBE_SYNC; ++r_) xcd_barrier(bar); } } while (0)

    LAS float* scr = (LAS float*)(lds + wave * 16640);
    constexpr int I_IN = (D / 64) * (DIN / 64), I_OUT = (D / 64) * (D / 64), I_FI = (D / 64) * (2 * DFF / 64), I_FO = (DFF / 64) * (D / 64), NITEMS = I_IN + I_OUT + I_FI + I_FO;
    constexpr int CONV_WG_ITEMS = (NITEMS - I_IN) / 32;
    static_assert((NITEMS - I_IN) % 32 == 0, "deferred conversion items");
#define P0_DECODE(it_, src_, dst_, N_, K_) do { int r_ = (it_); \
            if (r_ < I_IN) { const int kb = r_ / (DIN / 64), nb = r_ % (DIN / 64); N_ = DIN; K_ = D; src_ = args.in[2] + (size_t)(64 * kb) * DIN + 64 * nb; dst_ = WinT + (size_t)(64 * nb) * D + 64 * kb; } \
            else if ((r_ -= I_IN) < I_OUT) { const int kb = r_ / (D / 64), nb = r_ % (D / 64); N_ = D; K_ = D; src_ = args.in[15] + (size_t)(64 * kb) * D + 64 * nb; dst_ = WoutT + (size_t)(64 * nb) * D + 64 * kb; } \
            else if ((r_ -= I_OUT) < I_FI) { const int kb = r_ / (2 * DFF / 64), nb = r_ % (2 * DFF / 64), n0d = 64 * nb, pn = n0d >> 8, within = n0d & 255; const int n0s = (within < 128 ? 0 : DFF) + 128 * pn + (within & 127); \
                N_ = 2 * DFF; K_ = D; src_ = args.in[18] + (size_t)(64 * kb) * (2 * DFF) + n0s; dst_ = WfiT + (size_t)n0d * D + 64 * kb; } \
            else { r_ -= I_FI; const int kb = r_ / (D / 64), nb = r_ % (D / 64); N_ = D; K_ = DFF; src_ = args.in[19] + (size_t)(64 * kb) * D + 64 * nb; dst_ = WfoT + (size_t)(64 * nb) * DFF + 64 * kb; } } while (0)
#define CONVERT_RANGE(first_, end_, stride_, nt_) do { \
            f32x4 nxt[16]; const float* src = nullptr; bf16* dst = nullptr; size_t N = 0, K = 0; \
            int it = (first_); bool have = it < (end_); \
            if (have) { P0_DECODE(it, src, dst, N, K); p0_load_item(nxt, src, N, lane); } \
            while (have) { \
                f32x4 cur[16]; \
                _Pragma("unroll") for (int i = 0; i < 16; ++i) cur[i] = nxt[i]; \
                bf16* cdst = dst; const size_t cK = K; \
                it += (stride_); have = it < (end_); \
                if (have) { P0_DECODE(it, src, dst, N, K); p0_load_item(nxt, src, N, lane); } \
                p0_store_item<nt_>(cur, cdst, cK, scr, lane); \
            } } while (0)
#define WG_FETCH(ctr_, out_) do { __syncthreads(); if (tid == 0) MISC[16] = __hip_atomic_fetch_add((ctr_), 1u, __ATOMIC_RELAXED, __HIP_MEMORY_SCOPE_AGENT); __syncthreads(); out_ = (int)MISC[16]; } while (0)

    if (IN(0)) for (int rep = 0; rep < NREP(0); ++rep) {
        CONVERT_RANGE(gw, I_IN, NGW, false);
        for (int m = gw; m < M; m += NGW) rms_row_to_bf16(x + (size_t)m * D, args.in[1], XN + (size_t)m * D, lane);
        for (int i = bx * 512 + tid; i < 2048; i += G * 512) SP[i] = log1pf(expf(-args.in[12][i]));
    }
    SEAM(0);
    if (IN(1)) for (int rep = 0; rep < NREP(1); ++rep) {
        pg8::Gemm g{XN, WinT, M, DIN, D}; pg8::StaticOrder S; S.init(M, DIN, G, bx);
        pg8::EpiProj E{PROJ};
        pg8::gemm_phase<pg8::EpiProj, pg8::StaticOrder, false, true>(lds, g, S, E);
    }
    SEAM(1);
    if (IN(2)) for (int rep = 0; rep < NREP(2); ++rep) {
        unsigned* qmix = (unsigned*)(ws + WS_CTL) + 8192 + 256 * rep; unsigned* qconv = qmix + 64;
        const bool conv_first = ((bx >> 3) & 7) >= 3;
        for (int pass = 0; pass < 2; ++pass) {
            if ((pass == 0) == conv_first) {
                for (;;) { int ci; WG_FETCH(qconv, ci); if (ci >= CONV_WG_ITEMS) break;
                    const int first = I_IN + ci * 32 + wave; CONVERT_RANGE(first, I_IN + ci * 32 + 32, 8, true); }
            } else {
                for (;;) { int u; WG_FETCH(qmix, u); if (u >= 1280) break;
                    if (u < 256) rglru_local_unit(lds, u, PROJ, args.in[8], args.in[10], args.in[9], args.in[11], args.in[6], args.in[7], SP, HL, PC, AGGP, AGGH);
                    else gmlp_unit(lds, u - 256, PROJ, args.in[4], args.in[5], args.in[3], args.in[13], Y, SSA); }
            }
        }
        __syncthreads();
    }
    SEAM(2);
    if (IN(3)) for (int rep = 0; rep < NREP(3); ++rep) {
        for (int u = bx; u < 256; u += G) rglru_final_unit(u, PROJ, HL, PC, AGGP, AGGH, args.in[14], Y, SSB);
    }
    SEAM(3);
    if (IN(4)) for (int rep = 0; rep < NREP(4); ++rep) {
        pg8::Gemm g{Y, WoutT, M, D, D}; pg8::StaticOrder S; S.init(M, D, G, bx);
        { pg8::Unit u;
          for (int i = 0; i < 8 && S.next(i, u); ++i) {
              if (tid < 256) { const int row = u.pm * 256 + tid; const f32x4* pa = (const f32x4*)(SSA + (size_t)row * 16); const f32x4* pb = (const f32x4*)(SSB + (size_t)row * 16);
                  float sa = 0.f, sb = 0.f;
#pragma unroll
                  for (int j = 0; j < 4; ++j) { const f32x4 a = pa[j], b = pb[j]; sa += (a.x + a.y) + (a.z + a.w); sb += (b.x + b.y) + (b.z + b.w); }
                  const float rsa = 1.0f / sqrtf(sa * (1.0f / DA) + EPS), rsb = 1.0f / sqrtf(sb * (1.0f / DA) + EPS);
                  *(LAS f32x2v*)(lds + RSL_OFF + (size_t)(i * 256 + tid) * 8) = (f32x2v){rsa / rsb, rsb}; } }
          __syncthreads(); }
        pg8::EpiRows<true> E{O1, SS1, lds + RSL_OFF};
        pg8::gemm_phase<pg8::EpiRows<true>, pg8::StaticOrder, false, true>(lds, g, S, E);
    }
    SEAM(4);
    if (IN(5)) for (int rep = 0; rep < NREP(5); ++rep) {
        for (int row = gw; row < M; row += NGW) {
            const float rs1 = 1.0f / sqrtf(wave_sum(SS1[(size_t)row * 64 + lane]) * (1.0f / D) + EPS);
            f32x4 x1[16]; float s2 = 0.f;
#pragma unroll
            for (int j = 0; j < 16; ++j) { const int col = 4 * lane + 256 * j;
                const f32x4 xv = __builtin_nontemporal_load((const f32x4*)(x + (size_t)row * D + col)); const v2u o = *(const v2u*)(O1 + (size_t)row * D + col); const f32x4 g = *(const f32x4*)(args.in[16] + col);
                f32x4 v; v.x = xv.x + bflo(o.x) * rs1 * g.x; v.y = xv.y + bfhi(o.x) * rs1 * g.y; v.z = xv.z + bflo(o.y) * rs1 * g.z; v.w = xv.w + bfhi(o.y) * rs1 * g.w;
                x1[j] = v; s2 += (v.x * v.x + v.y * v.y) + (v.z * v.z + v.w * v.w); }
            const float rs2 = 1.0f / sqrtf(wave_sum(s2) * (1.0f / D) + EPS);
#pragma unroll
            for (int j = 0; j < 16; ++j) { const int col = 4 * lane + 256 * j; const f32x4 g = *(const f32x4*)(args.in[17] + col);
                v2u o; o.x = cvtpk(x1[j].x * rs2 * g.x, x1[j].y * rs2 * g.y); o.y = cvtpk(x1[j].z * rs2 * g.z, x1[j].w * rs2 * g.w);
                *(v2u*)(XN + (size_t)row * D + col) = o; }
        }
    }
    SEAM(5);
    if (IN(6)) for (int rep = 0; rep < NREP(6); ++rep) {
        pg8::Gemm g{XN, WfiT, M, 2 * DFF, D}; pg8::StaticOrder S; S.init(M, 2 * DFF, G, bx);
        pg8::EpiSwiGLU E{ACT};
        pg8::gemm_phase<pg8::EpiSwiGLU, pg8::StaticOrder, false, true>(lds, g, S, E);
    }
    SEAM(6);
    if (IN(7)) for (int rep = 0; rep < NREP(7); ++rep) {
        pg8::Gemm g{ACT, WfoT, M, D, DFF}; pg8::StaticOrder S; S.init(M, D, G, bx);
        pg8::EpiRows<false> E{FB, SS2, lds + RSL_OFF};
        pg8::gemm_phase<pg8::EpiRows<false>, pg8::StaticOrder, false, true>(lds, g, S, E);
    }
    SEAM(7);
    if (IN(8)) for (int rep = 0; rep < NREP(8); ++rep) {
        float* dst = (rep + 1 == NREP(8)) ? out : (float*)(ws + WS_HL);
        for (int row = gw; row < M; row += NGW) {
            const float rs = 1.0f / sqrtf(wave_sum(SS2[(size_t)row * 64 + lane]) * (1.0f / D) + EPS);
            const float rs1 = 1.0f / sqrtf(wave_sum(SS1[(size_t)row * 64 + lane]) * (1.0f / D) + EPS);
#pragma unroll
            for (int j = 0; j < 16; ++j) { const int col = 4 * lane + 256 * j;
                const f32x4 xv = __builtin_nontemporal_load((const f32x4*)(x + (size_t)row * D + col)); const v2u o1 = *(const v2u*)(O1 + (size_t)row * D + col); const f32x4 g1 = *(const f32x4*)(args.in[16] + col);
                const v2u o = *(const v2u*)(FB + (size_t)row * D + col); const f32x4 g = *(const f32x4*)(args.in[20] + col);
                f32x4 v; v.x = xv.x + bflo(o1.x) * rs1 * g1.x; v.y = xv.y + bfhi(o1.x) * rs1 * g1.y; v.z = xv.z + bflo(o1.y) * rs1 * g1.z; v.w = xv.w + bfhi(o1.y) * rs1 * g1.w;
                v.x = v.x + bflo(o.x) * rs * g.x; v.y = v.y + bfhi(o.x) * rs * g.y; v.z = v.z + bflo(o.y) * rs * g.z; v.w = v.w + bfhi(o.y) * rs * g.w;
                __builtin_nontemporal_store(v, (f32x4*)(dst + (size_t)row * D + col)); }
        }
    }
#undef IN
#undef SEAM
#undef P0_DECODE
#undef CONVERT_RANGE
#undef WG_FETCH
}

extern "C" void kernel_launch(void* const* d_in, const int* in_sizes, int n_in, void* d_out, int out_size, void* d_ws, size_t ws_size, hipStream_t stream) {
    static int grid = 0;
    if (grid == 0) {
        if (n_in != 21 || out_size != M * D || ws_size < WS_END) { fprintf(stderr, "kernel_launch: unexpected problem (n_in %d, out %d, ws %zu)\n", n_in, out_size, ws_size); grid = -1; return; }
        int dev = 0, cus = 0, per_cu = 0;
        if (hipGetDevice(&dev) != hipSuccess || hipDeviceGetAttribute(&cus, hipDeviceAttributeMultiprocessorCount, dev) != hipSuccess) { grid = -1; return; }
        if (hipFuncSetAttribute((const void*)mk_fwd, hipFuncAttributeMaxDynamicSharedMemorySize, LDS_BYTES) != hipSuccess) { fprintf(stderr, "kernel_launch: hipFuncSetAttribute failed\n"); grid = -1; return; }
        if (hipOccupancyMaxActiveBlocksPerMultiprocessor(&per_cu, (const void*)mk_fwd, NWAVES * 64, LDS_BYTES) != hipSuccess || per_cu < 1) per_cu = 1;
        (void)hipGetLastError();
        grid = cus * per_cu;
        fprintf(stderr, "kernel_launch: %d CUs x %d -> grid %d\n", cus, per_cu, grid);
    }
    if (grid < 0) return;
    if (hipMemsetAsync((char*)d_ws + WS_CTL, 0, CTL_ZERO_BYTES, stream) != hipSuccess) { fprintf(stderr, "kernel_launch: hipMemsetAsync failed\n"); return; }
    Args a{};
    for (int i = 0; i < 21; ++i) a.in[i] = (const float*)d_in[i];
    a.out = (float*)d_out; a.ws = (unsigned char*)d_ws;
#if MK_N_LAUNCHES == 1
    a.ph_lo = 0; a.ph_hi = N_PHASES;
    void* kargs[] = {&a};
    hipError_t e = hipLaunchCooperativeKernel((const void*)mk_fwd, dim3(grid), dim3(NWAVES * 64), kargs, LDS_BYTES, stream);
    if (e != hipSuccess) fprintf(stderr, "kernel_launch: cooperative launch failed: %s (grid %d)\n", hipGetErrorString(e), grid);
#else
    for (int p = 0; p < N_PHASES; ++p) { a.ph_lo = p; a.ph_hi = p + 1; hipLaunchKernelGGL(mk_fwd, dim3(grid), dim3(NWAVES * 64), LDS_BYTES, stream, a); }
#endif
}
```

```cpp
#include <hip/hip_runtime.h>
#include <hip/hip_cooperative_groups.h>
#include <cstdio>
#include <cstdint>
namespace cg = cooperative_groups;
#ifndef MK_N_LAUNCHES
#define MK_N_LAUNCHES 1
#endif
namespace pg8 {
#define PG8_LAS __attribute__((address_space(3)))
typedef unsigned short bf16_t;
typedef short bf16x8 __attribute__((ext_vector_type(8)));
typedef float f32x4 __attribute__((ext_vector_type(4)));
typedef unsigned u32x4 __attribute__((ext_vector_type(4)));
constexpr int BM = 256, BK = 64, HALF = 128, HTB = HALF * BK * 2  , STAGE_BYTES = 8 * HTB, NXCD = 8, WGM = 8;

__host__ __device__ __forceinline__ int lds_byte(int r, int c) { const int st = (r >> 4) * 2 + (c >> 5), rr = r & 15, cc = c & 31, ob = rr * 64 + cc * 2; return st * 1024 + (ob ^ (((ob >> 9) & 1) << 5)); }
__host__ __device__ __forceinline__ void stage_rc(int b, int& R, int& C) { const int st = b / 1024, sb = b % 1024, swz = sb ^ (((sb >> 9) & 1) << 5); R = (st >> 1) * 16 + swz / 64; C = (st & 1) * 32 + (swz % 64) / 2; }
__host__ __device__ __forceinline__ int perm32(int rho) { const int n = rho >> 4, i = rho & 15; return 8 * (i >> 2) + 4 * n + (i & 3); }

struct Unit { int pm, pn; };
struct Gemm { const bf16_t* A; const bf16_t* Bt; int M, N, K; };

struct StaticOrder {
    int nM, nN, nwg, G, c;
    __host__ __device__ void init(int M, int N, int G_, int c_) { nM = M / BM; nN = N / BM; nwg = nM * nN; G = G_; c = c_; }
    __host__ __device__ bool next(int i, Unit& u) const {
        const long L = (long)i * G + c; if (L >= nwg) return false;
        int wgid = (int)L; { const int q = nwg / NXCD, r = nwg % NXCD, xcd = wgid % NXCD, off = wgid / NXCD; wgid = (xcd < r ? xcd * (q + 1) : r * (q + 1) + (xcd - r) * q) + off; }
        const int nig = WGM * nN, gid = wgid / nig, fm = gid * WGM, gsz = (nM - fm) < WGM ? (nM - fm) : WGM;
        u.pm = fm + ((wgid % nig) % gsz); u.pn = (wgid % nig) / gsz; return true;
    }
    __device__ __forceinline__ void a_ready(const Unit&) const {}
    __device__ __forceinline__ void done(const Unit&) const {}
};
__device__ __forceinline__ unsigned cvt_pk_bf16(float lo, float hi) { unsigned r; asm volatile("v_cvt_pk_bf16_f32 %0, %1, %2" : "=v"(r) : "v"(lo), "v"(hi)); return r; }

template <class Epi, class Sched, bool ALIGN_EPI = false, bool SP2 = false>
__device__ __forceinline__ void gemm_phase(PG8_LAS unsigned char* lds, const Gemm g, const Sched& S, const Epi& E) {
    const int tid = threadIdx.x, wid = __builtin_amdgcn_readfirstlane(tid >> 6), lane = tid & 63, wr = wid >> 2, wc = wid & 3, fr = lane & 15, fq = lane >> 4;
    const int K = g.K, nt = K / BK;
    unsigned voffA[2], voffB[2];
#pragma unroll
    for (int i = 0; i < 2; ++i) { int R, C; stage_rc(tid * 16 + i * 8192, R, C); const int Rb = Epi::PERM ? ((R & ~31) + perm32(R & 31)) : R;
        voffA[i] = (unsigned)(R * K + C) * 2u; voffB[i] = (unsigned)(Rb * K + C) * 2u; }
    const size_t kstep = (size_t)(BK * 2);
    const size_t hstep = (size_t)HALF * K * 2;
    const size_t tstep = 2 * hstep;
    const unsigned ldsw = (unsigned)wid * 1024u;
    const int aoff = lds_byte(wr * 64 + fr, fq * 8), boff = lds_byte(wc * 32 + fr, fq * 8);
#define PG8_SA(b, h) (((b) * 2 + (h)) * HTB)
#define PG8_SB(b, h) ((4 + (b) * 2 + (h)) * HTB)
#define PG8_STAGE(bufoff, gbase, voff) do { _Pragma("unroll") for (int _i = 0; _i < 2; ++_i) \
        __builtin_amdgcn_global_load_lds((const unsigned*)((const char*)(gbase) + (voff)[_i]), (PG8_LAS unsigned*)(lds + (bufoff) + ldsw + _i * 8192), 16, 0, 0); } while (0)
#define PG8_LDA(dst, b, h) do { _Pragma("unroll") for (int m = 0; m < 4; ++m) _Pragma("unroll") for (int k = 0; k < 2; ++k) dst[m][k] = *(const PG8_LAS bf16x8*)(lds + PG8_SA(b, h) + aoff + m * 2048 + k * 1024); } while (0)
#define PG8_LDB(dst, b, h) do { _Pragma("unroll") for (int n = 0; n < 2; ++n) _Pragma("unroll") for (int k = 0; k < 2; ++k) dst[n][k] = *(const PG8_LAS bf16x8*)(lds + PG8_SB(b, h) + boff + n * 2048 + k * 1024); } while (0)
#define PG8_MMA(ai, bj, At, Bt) do { __builtin_amdgcn_s_setprio(1); _Pragma("unroll") for (int m = 0; m < 4; ++m) _Pragma("unroll") for (int n = 0; n < 2; ++n) _Pragma("unroll") for (int k = 0; k < 2; ++k) \
        acc[ai][bj][m][n] = __builtin_amdgcn_mfma_f32_16x16x32_bf16(Bt[n][k], At[m][k], acc[ai][bj][m][n], 0, 0, 0); __builtin_amdgcn_s_setprio(0); } while (0)
#define PG8_WAIT_V(n) asm volatile("s_waitcnt vmcnt(" #n ")" ::: "memory")
#define PG8_WAIT_L(n) asm volatile("s_waitcnt lgkmcnt(" #n ")" ::: "memory")
#define PG8_BAR __builtin_amdgcn_s_barrier()
#define PG8_SCHED __builtin_amdgcn_sched_barrier(0)
    Unit cur, nxt; int ui = 0;
    if (!S.next(0, cur)) return;
    f32x4 acc[2][2][4][2];
#pragma unroll
    for (int a = 0; a < 2; ++a)
#pragma unroll
        for (int b = 0; b < 2; ++b)
#pragma unroll
            for (int m = 0; m < 4; ++m)
#pragma unroll
                for (int n = 0; n < 2; ++n) acc[a][b][m][n] = (f32x4){0.f, 0.f, 0.f, 0.f};
    bf16x8 At[4][2], B0[2][2], B1[2][2];
    const char* cA = (const char*)g.A + (size_t)cur.pm * tstep; const char* cB = (const char*)g.Bt + (size_t)cur.pn * tstep;
    S.a_ready(cur);
    if constexpr (SP2) {
        PG8_STAGE(PG8_SB(0, 0), cB, voffB); PG8_STAGE(PG8_SB(0, 1), cB + hstep, voffB); PG8_STAGE(PG8_SA(0, 0), cA, voffA); PG8_STAGE(PG8_SA(0, 1), cA + hstep, voffA);
        if (wr == 1) PG8_BAR;
        PG8_WAIT_V(2); PG8_BAR;
        PG8_STAGE(PG8_SB(1, 0), cB + kstep, voffB); PG8_STAGE(PG8_SA(1, 0), cA + kstep, voffA); PG8_STAGE(PG8_SB(1, 1), cB + hstep + kstep, voffB);
        PG8_WAIT_V(6); PG8_BAR;
    } else {
        PG8_STAGE(PG8_SB(0, 0), cB, voffB); PG8_STAGE(PG8_SA(0, 0), cA, voffA); PG8_STAGE(PG8_SB(0, 1), cB + hstep, voffB); PG8_STAGE(PG8_SA(0, 1), cA + hstep, voffA);
        if (wr == 1) PG8_BAR;
        PG8_WAIT_V(4); PG8_BAR;
        PG8_STAGE(PG8_SB(1, 0), cB + kstep, voffB); PG8_STAGE(PG8_SA(1, 0), cA + kstep, voffA); PG8_STAGE(PG8_SB(1, 1), cB + hstep + kstep, voffB);
        PG8_WAIT_V(6); PG8_BAR;
    }
    for (;;) {
        const bool has_next = S.next(ui + 1, nxt);
        const char* nA = has_next ? (const char*)g.A + (size_t)nxt.pm * tstep : cA; const char* nB = has_next ? (const char*)g.Bt + (size_t)nxt.pn * tstep : cB;
        for (int t = 0; t < nt; t += 2) {
            if constexpr (Epi::MID) { if (t == (nt >> 1)) E.mid(acc, ui, wr, fr); }
            const bool last = (t == nt - 2);
            const char* a1 = cA + (size_t)(t + 1) * kstep;
            const char* a2 = last ? nA : cA + (size_t)(t + 2) * kstep; const char* b2 = last ? nB : cB + (size_t)(t + 2) * kstep;
            const char* a3 = a2 + kstep; const char* b3 = b2 + kstep;
            if (last && has_next) S.a_ready(nxt);
            if constexpr (SP2) {
            PG8_LDB(B0, 0, 0); PG8_LDB(B1, 0, 1); PG8_SCHED; PG8_LDA(At, 0, 0); PG8_STAGE(PG8_SA(1, 1), a1 + hstep, voffA);
            PG8_WAIT_V(8); PG8_WAIT_L(0); PG8_BAR; PG8_MMA(0, 0, At, B0); PG8_MMA(0, 1, At, B1); PG8_BAR; PG8_SCHED;
            PG8_LDA(At, 0, 1); PG8_STAGE(PG8_SB(0, 0), b2, voffB); PG8_STAGE(PG8_SB(0, 1), b2 + hstep, voffB); PG8_STAGE(PG8_SA(0, 0), a2, voffA);
            PG8_WAIT_V(8); PG8_WAIT_L(0); PG8_BAR; PG8_MMA(1, 0, At, B0); PG8_MMA(1, 1, At, B1); PG8_BAR; PG8_SCHED;
            PG8_LDB(B0, 1, 0); PG8_LDB(B1, 1, 1); PG8_SCHED; PG8_LDA(At, 1, 0); PG8_STAGE(PG8_SA(0, 1), a2 + hstep, voffA);
            PG8_WAIT_V(8); PG8_WAIT_L(0); PG8_BAR; PG8_MMA(0, 0, At, B0); PG8_MMA(0, 1, At, B1); PG8_BAR; PG8_SCHED;
            PG8_LDA(At, 1, 1); PG8_STAGE(PG8_SB(1, 0), b3, voffB); PG8_STAGE(PG8_SB(1, 1), b3 + hstep, voffB); PG8_STAGE(PG8_SA(1, 0), a3, voffA);
            PG8_WAIT_V(8); PG8_WAIT_L(0); PG8_BAR; PG8_MMA(1, 0, At, B0); PG8_MMA(1, 1, At, B1); PG8_BAR; PG8_SCHED;
            } else {
            PG8_LDB(B0, 0, 0); PG8_SCHED; PG8_LDA(At, 0, 0); PG8_STAGE(PG8_SA(1, 1), a1 + hstep, voffA);
            PG8_WAIT_L(8); PG8_BAR; PG8_WAIT_L(0); PG8_MMA(0, 0, At, B0); PG8_BAR; PG8_SCHED;
            PG8_LDB(B1, 0, 1); PG8_STAGE(PG8_SB(0, 0), b2, voffB);
            PG8_BAR; PG8_WAIT_L(0); PG8_MMA(0, 1, At, B1); PG8_BAR;
            PG8_LDA(At, 0, 1); PG8_STAGE(PG8_SA(0, 0), a2, voffA);
            PG8_BAR; PG8_WAIT_L(0); PG8_MMA(1, 0, At, B0); PG8_BAR; PG8_SCHED;
            PG8_STAGE(PG8_SB(0, 1), b2 + hstep, voffB);
            PG8_WAIT_V(6); PG8_BAR; PG8_MMA(1, 1, At, B1); PG8_BAR;
            PG8_LDB(B0, 1, 0); PG8_SCHED; PG8_LDA(At, 1, 0); PG8_STAGE(PG8_SA(0, 1), a2 + hstep, voffA);
            PG8_WAIT_L(8); PG8_BAR; PG8_WAIT_L(0); PG8_MMA(0, 0, At, B0); PG8_BAR; PG8_SCHED;
            PG8_LDB(B1, 1, 1); PG8_STAGE(PG8_SB(1, 0), b3, voffB);
            PG8_BAR; PG8_WAIT_L(0); PG8_MMA(0, 1, At, B1); PG8_BAR;
            PG8_LDA(At, 1, 1); PG8_STAGE(PG8_SA(1, 0), a3, voffA);
            PG8_BAR; PG8_WAIT_L(0); PG8_MMA(1, 0, At, B0); PG8_BAR; PG8_SCHED;
            PG8_STAGE(PG8_SB(1, 1), b3 + hstep, voffB);
            PG8_WAIT_V(6); PG8_BAR; PG8_MMA(1, 1, At, B1); PG8_BAR;
            }
        }
        if constexpr (ALIGN_EPI) { if (wr == 0) PG8_BAR; }
        if constexpr (!Epi::AFTER_DRAIN) { E(acc, cur, ui, wr, wc, fr, fq); S.done(cur); }
        if (!has_next) break;
#pragma unroll
        for (int a = 0; a < 2; ++a)
#pragma unroll
            for (int b = 0; b < 2; ++b)
#pragma unroll
                for (int m = 0; m < 4; ++m)
#pragma unroll
                    for (int n = 0; n < 2; ++n) acc[a][b][m][n] = (f32x4){0.f, 0.f, 0.f, 0.f};
        cur = nxt; cA = nA; cB = nB; ++ui;
        if constexpr (ALIGN_EPI) { if (wr == 1) PG8_BAR; }
    }
    PG8_WAIT_V(0);
    if constexpr (!ALIGN_EPI) { if (wr == 0) PG8_BAR; }
    PG8_BAR;
#undef PG8_SA
#undef PG8_SB
#undef PG8_STAGE
#undef PG8_LDA
#undef PG8_LDB
#undef PG8_MMA
#undef PG8_WAIT_V
#undef PG8_WAIT_L
#undef PG8_BAR
#undef PG8_SCHED
}
}

#define LAS __attribute__((address_space(3)))
typedef unsigned short bf16;
typedef unsigned v4u __attribute__((ext_vector_type(4)));
typedef unsigned v2u __attribute__((ext_vector_type(2)));
typedef float f32x4 __attribute__((ext_vector_type(4)));
typedef float f32x2v __attribute__((ext_vector_type(2)));
typedef short bf16x8 __attribute__((ext_vector_type(8)));

constexpr int NWAVES = 8;
constexpr int M = 8192, D = 4096, DIN = 8192, DA = 2048, DFF = 11008, SEQ = 2048;
constexpr float EPS = 1e-6f, LOG2E = 1.4426950408889634f;
constexpr size_t MiB = 1u << 20;
constexpr size_t WS_WIN = 0, WS_WOUT = 64 * MiB, WS_WFI = 96 * MiB, WS_WFO = 268 * MiB, WS_XN = 354 * MiB, WS_PROJ = 418 * MiB, WS_Y = 546 * MiB,
                 WS_HL = 610 * MiB, WS_PC = 674 * MiB, WS_O1 = 738 * MiB, WS_ACT = 802 * MiB, WS_SSA = 974 * MiB, WS_SSB = WS_SSA + 512 * 1024,
                 WS_SS1 = 975 * MiB, WS_SS2 = 977 * MiB, WS_AGGP = 979 * MiB, WS_AGGH = 980 * MiB, WS_SP = 981 * MiB, WS_CTL = 982 * MiB, WS_END = 983 * MiB;
constexpr size_t CTL_ZERO_BYTES = 65536;
constexpr int RING_BYTES = 131072, RSL_OFF = RING_BYTES, MISC_OFF = RING_BYTES + 16384, LDS_BYTES = MISC_OFF + 256;

#define LDS_WAIT() asm volatile("s_waitcnt lgkmcnt(0)" ::: "memory")
__device__ __forceinline__ unsigned cvtpk(float lo, float hi) { return pg8::cvt_pk_bf16(lo, hi); }
__device__ __forceinline__ float bflo(unsigned w) { return __builtin_bit_cast(float, w << 16); }
__device__ __forceinline__ float bfhi(unsigned w) { return __builtin_bit_cast(float, w & 0xffff0000u); }
__device__ __forceinline__ float wave_sum(float v) {
#pragma unroll
    for (int o = 1; o < 64; o <<= 1) v += __shfl_xor(v, o);
    return v;
}
__device__ __forceinline__ float fexp2(float x) { return __builtin_amdgcn_exp2f(x); }
__device__ __forceinline__ float frcp(float x) { return __builtin_amdgcn_rcpf(x); }
__device__ __forceinline__ float gelu_tanh(float x) { const float z = x * (1.0f + 0.044715f * x * x); return x * frcp(1.0f + fexp2(-2.302208198f * z)); }
__device__ __forceinline__ float sigmoidf_(float x) { return frcp(1.0f + fexp2(-LOG2E * x)); }
template <int CTRL> __device__ __forceinline__ float dpp_f(float old, float src) {
    return __builtin_bit_cast(float, __builtin_amdgcn_update_dpp(__builtin_bit_cast(int, old), __builtin_bit_cast(int, src), CTRL, 0xf, 0xf, false));
}

namespace pg8 {
struct EpiProj {
    static constexpr bool PERM = true, AFTER_DRAIN = false, MID = false;
    bf16_t* O;
    __device__ __forceinline__ void mid(f32x4 (&)[2][2][4][2], int, int, int) const {}
    __device__ __forceinline__ void operator()(const f32x4 (&acc)[2][2][4][2], const Unit& u, int ui, int wr, int wc, int fr, int fq) const {
        const bool act = u.pn < 24;
        const int row0 = u.pm * BM + wr * 64 + fr, col0 = u.pn * BM + wc * 32 + 8 * fq;
#pragma unroll
        for (int ai = 0; ai < 2; ++ai)
#pragma unroll
            for (int m = 0; m < 4; ++m) { bf16_t* rowp = O + (size_t)(row0 + ai * HALF + m * 16) * DIN + col0;
#pragma unroll
                for (int bj = 0; bj < 2; ++bj) { f32x4 v0 = acc[ai][bj][m][0], v1 = acc[ai][bj][m][1];
                    if (act) {
#pragma unroll
                        for (int j = 0; j < 4; ++j) { v0[j] = gelu_tanh(v0[j]); v1[j] = gelu_tanh(v1[j]); } }
                    u32x4 w; w.x = cvt_pk_bf16(v0[0], v0[1]); w.y = cvt_pk_bf16(v0[2], v0[3]); w.z = cvt_pk_bf16(v1[0], v1[1]); w.w = cvt_pk_bf16(v1[2], v1[3]);
                    *(u32x4*)(rowp + bj * HALF) = w; } }
    }
};
template <bool SCALE> struct EpiRows {
    static constexpr bool PERM = true, AFTER_DRAIN = false, MID = SCALE;
    bf16_t* O; float* SS; PG8_LAS unsigned char* rsl;
    __device__ __forceinline__ void mid(f32x4 (&acc)[2][2][4][2], int ui, int wr, int fr) const {
        typedef float f2 __attribute__((ext_vector_type(2)));
#pragma unroll
        for (int ai = 0; ai < 2; ++ai)
#pragma unroll
            for (int m = 0; m < 4; ++m) { const int rl = ai * HALF + wr * 64 + m * 16 + fr; const f2 s = *(const PG8_LAS f2*)(rsl + (size_t)(ui * 256 + rl) * 8);
#pragma unroll
                for (int bj = 0; bj < 2; ++bj)
#pragma unroll
                    for (int n = 0; n < 2; ++n) acc[ai][bj][m][n] = acc[ai][bj][m][n] * s.x; }
    }
    __device__ __forceinline__ void operator()(const f32x4 (&acc)[2][2][4][2], const Unit& u, int ui, int wr, int wc, int fr, int fq) const {
        typedef float f2 __attribute__((ext_vector_type(2)));
        const int row0 = u.pm * BM + wr * 64 + fr, col0 = u.pn * BM + wc * 32 + 8 * fq;
#pragma unroll
        for (int ai = 0; ai < 2; ++ai)
#pragma unroll
            for (int m = 0; m < 4; ++m) { const int rl = ai * HALF + wr * 64 + m * 16 + fr; const int row = u.pm * BM + rl;
                float sc = 1.0f; if (SCALE) { const f2 s = *(const PG8_LAS f2*)(rsl + (size_t)(ui * 256 + rl) * 8); sc = s.y; }
                bf16_t* rowp = O + (size_t)row * 4096 + col0; float ss = 0.f;
#pragma unroll
                for (int bj = 0; bj < 2; ++bj) { const f32x4 v0 = acc[ai][bj][m][0] * sc, v1 = acc[ai][bj][m][1] * sc;
                    ss += (v0[0] * v0[0] + v0[1] * v0[1]) + (v0[2] * v0[2] + v0[3] * v0[3]) + (v1[0] * v1[0] + v1[1] * v1[1]) + (v1[2] * v1[2] + v1[3] * v1[3]);
                    u32x4 w; w.x = cvt_pk_bf16(v0[0], v0[1]); w.y = cvt_pk_bf16(v0[2], v0[3]); w.z = cvt_pk_bf16(v1[0], v1[1]); w.w = cvt_pk_bf16(v1[2], v1[3]);
                    *(u32x4*)(rowp + bj * HALF) = w; }
                ss += __shfl_xor(ss, 16); ss += __shfl_xor(ss, 32);
                if (fq == 0) SS[(size_t)row * 64 + u.pn * 4 + wc] = ss; }
    }
};
struct EpiSwiGLU {
    static constexpr bool PERM = true, AFTER_DRAIN = false, MID = false;
    bf16_t* O;
    __device__ __forceinline__ void mid(f32x4 (&)[2][2][4][2], int, int, int) const {}
    __device__ __forceinline__ void operator()(const f32x4 (&acc)[2][2][4][2], const Unit& u, int ui, int wr, int wc, int fr, int fq) const {
        const int row0 = u.pm * BM + wr * 64 + fr, col0 = u.pn * HALF + wc * 32 + 8 * fq;
#pragma unroll
        for (int ai = 0; ai < 2; ++ai)
#pragma unroll
            for (int m = 0; m < 4; ++m) { bf16_t* rowp = O + (size_t)(row0 + ai * HALF + m * 16) * 11008 + col0;
                f32x4 v0, v1;
#pragma unroll
                for (int j = 0; j < 4; ++j) { const float g0 = acc[ai][0][m][0][j], g1 = acc[ai][0][m][1][j];
                    v0[j] = g0 * __builtin_amdgcn_rcpf(1.0f + __builtin_amdgcn_exp2f(-1.4426950408889634f * g0)) * acc[ai][1][m][0][j];
                    v1[j] = g1 * __builtin_amdgcn_rcpf(1.0f + __builtin_amdgcn_exp2f(-1.4426950408889634f * g1)) * acc[ai][1][m][1][j]; }
                u32x4 w; w.x = cvt_pk_bf16(v0[0], v0[1]); w.y = cvt_pk_bf16(v0[2], v0[3]); w.z = cvt_pk_bf16(v1[0], v1[1]); w.w = cvt_pk_bf16(v1[2], v1[3]);
                *(u32x4*)rowp = w; }
    }
};
}

__device__ __forceinline__ void p0_load_item(f32x4 (&v)[16], const float* src, size_t N, int lane) {
    const float* p = src + (size_t)(lane >> 4) * N + 4 * (lane & 15);
#pragma unroll
    for (int i = 0; i < 16; ++i) v[i] = __builtin_nontemporal_load((const f32x4*)(p + (size_t)(4 * i) * N));
}
template <bool NT> __device__ __forceinline__ void p0_store_item(const f32x4 (&v)[16], bf16* dst, size_t K, LAS float* scr, int lane) {
    const int r = lane >> 4, c = lane & 15;
#pragma unroll
    for (int i = 0; i < 16; ++i) { LAS float* s = scr + (4 * i + r) * 65 + 4 * c; s[0] = v[i].x; s[1] = v[i].y; s[2] = v[i].z; s[3] = v[i].w; }
    LDS_WAIT(); asm volatile("" ::: "memory");
    const int c8 = lane & 7;
#pragma unroll
    for (int j = 0; j < 8; ++j) { const int n = (lane >> 3) + 8 * j; const LAS float* s = scr + (8 * c8) * 65 + n;
        v4u o; o.x = cvtpk(s[0 * 65], s[1 * 65]); o.y = cvtpk(s[2 * 65], s[3 * 65]); o.z = cvtpk(s[4 * 65], s[5 * 65]); o.w = cvtpk(s[6 * 65], s[7 * 65]);
        if (NT) __builtin_nontemporal_store(o, (v4u*)(dst + (size_t)n * K + 8 * c8)); else *(v4u*)(dst + (size_t)n * K + 8 * c8) = o; }
    LDS_WAIT(); asm volatile("" ::: "memory");
}
__device__ __forceinline__ void rms_row_to_bf16(const float* xrow, const float* g, bf16* orow, int lane) {
    const f32x4* xr = (const f32x4*)xrow + lane;
    f32x4 v[16]; float s = 0.f;
#pragma unroll
    for (int j = 0; j < 16; ++j) { v[j] = __builtin_nontemporal_load(xr + 64 * j); s += (v[j].x * v[j].x + v[j].y * v[j].y) + (v[j].z * v[j].z + v[j].w * v[j].w); }
    const float rs = 1.0f / sqrtf(wave_sum(s) * (1.0f / D) + EPS);
    v2u* o8 = (v2u*)orow + lane; const f32x4* gp = (const f32x4*)g + lane;
#pragma unroll
    for (int j = 0; j < 16; ++j) { const f32x4 gg = gp[64 * j]; v2u o; o.x = cvtpk(v[j].x * rs * gg.x, v[j].y * rs * gg.y); o.y = cvtpk(v[j].z * rs * gg.z, v[j].w * rs * gg.w); o8[64 * j] = o; }
}

__device__ __forceinline__ void gmlp_unit(LAS unsigned char* lds, int unit, const bf16* PROJ, const float* WSP, const float* BSP, const float* GV, const float* GOA, bf16* Y, float* SSA) {
    const int tid = threadIdx.x, lane = tid & 63, w = __builtin_amdgcn_readfirstlane(tid >> 6), c16 = lane & 15, q = lane >> 4;
    const int h = unit & 15, tok0 = (unit >> 4) * 128;
    LAS bf16* VT = (LAS bf16*)lds;
    const int trow = 16 * w + c16, nks = (16 * w + 15) / 32 + 1;
    f32x4 wq[4][2];
#pragma unroll
    for (int ks = 0; ks < 4; ++ks) { wq[ks][0] = (f32x4){0.f, 0.f, 0.f, 0.f}; wq[ks][1] = wq[ks][0];
        if (ks < nks) { const float* wp = WSP + ((size_t)h * 128 + trow) * 128 + 32 * ks + 8 * q; wq[ks][0] = *(const f32x4*)wp; wq[ks][1] = *(const f32x4*)(wp + 4); } }
    v2u uq[8];
#pragma unroll
    for (int db = 0; db < 8; ++db) uq[db] = *(const v2u*)(PROJ + (size_t)(tok0 + 16 * w + c16) * DIN + h * 128 + 16 * db + 4 * q);
    {   const int c = tid & 15;
#pragma unroll
        for (int i = 0; i < 4; ++i) { const int s = (tid >> 4) + 32 * i;
            const v4u raw = *(const v4u*)(PROJ + (size_t)(tok0 + s) * DIN + 2048 + h * 128 + 8 * c);
            float f[8]; f[0] = bflo(raw.x); f[1] = bfhi(raw.x); f[2] = bflo(raw.y); f[3] = bfhi(raw.y); f[4] = bflo(raw.z); f[5] = bfhi(raw.z); f[6] = bflo(raw.w); f[7] = bfhi(raw.w);
            float ss = 0.f;
#pragma unroll
            for (int k = 0; k < 8; ++k) ss += f[k] * f[k];
            ss += __shfl_xor(ss, 1); ss += __shfl_xor(ss, 2); ss += __shfl_xor(ss, 4); ss += __shfl_xor(ss, 8);
            const float rs = 1.0f / sqrtf(ss * (1.0f / 128.0f) + EPS);
#pragma unroll
            for (int k = 0; k < 4; ++k) { const unsigned pk = cvtpk(f[2 * k] * rs, f[2 * k + 1] * rs);
                const int sp_ = (((s >> 3) ^ c) << 3) | (s & 7);
                VT[(8 * c + 2 * k) * 136 + sp_] = (bf16)(pk & 0xffffu); VT[(8 * c + 2 * k + 1) * 136 + sp_] = (bf16)(pk >> 16); } }
    }
    __syncthreads();
    f32x4 acc[8];
#pragma unroll
    for (int db = 0; db < 8; ++db) acc[db] = (f32x4){0.f, 0.f, 0.f, 0.f};
#pragma unroll
    for (int ks = 0; ks < 4; ++ks) if (ks < nks) {
        const f32x4 w0 = wq[ks][0], w1 = wq[ks][1];
        const int sb = 32 * ks + 8 * q;
        float wv[8] = {w0.x, w0.y, w0.z, w0.w, w1.x, w1.y, w1.z, w1.w};
#pragma unroll
        for (int j = 0; j < 8; ++j) wv[j] = (sb + j <= trow) ? wv[j] : 0.f;
        v4u wpk; wpk.x = cvtpk(wv[0], wv[1]); wpk.y = cvtpk(wv[2], wv[3]); wpk.z = cvtpk(wv[4], wv[5]); wpk.w = cvtpk(wv[6], wv[7]);
        const bf16x8 wf = __builtin_bit_cast(bf16x8, wpk);
#pragma unroll
        for (int db = 0; db < 8; ++db) { const bf16x8 vf = *(const LAS bf16x8*)(VT + (16 * db + c16) * 136 + (((4 * ks + q) ^ ((16 * db + c16) >> 3)) << 3));
            acc[db] = __builtin_amdgcn_mfma_f32_16x16x32_bf16(vf, wf, acc[db], 0, 0, 0); }
    }
    const int tok = tok0 + 16 * w + c16; const float bsp = BSP[h * 128 + 16 * w + c16]; float ssq = 0.f;
#pragma unroll
    for (int db = 0; db < 8; ++db) { const int dcol = h * 128 + 16 * db + 4 * q;
        const v2u ur = uq[db]; const f32x4 g = *(const f32x4*)(GV + dcol);
        const float y0 = bflo(ur.x) * (g.x * acc[db][0] + bsp), y1 = bfhi(ur.x) * (g.y * acc[db][1] + bsp), y2 = bflo(ur.y) * (g.z * acc[db][2] + bsp), y3 = bfhi(ur.y) * (g.w * acc[db][3] + bsp);
        ssq += (y0 * y0 + y1 * y1) + (y2 * y2 + y3 * y3);
        const f32x4 go = *(const f32x4*)(GOA + dcol); v2u o; o.x = cvtpk(y0 * go.x, y1 * go.y); o.y = cvtpk(y2 * go.z, y3 * go.w); *(v2u*)(Y + (size_t)tok * D + dcol) = o; }
    ssq += __shfl_xor(ssq, 16); ssq += __shfl_xor(ssq, 32);
    if (q == 0) SSA[(size_t)tok * 16 + h] = ssq;
    __syncthreads();
}

__device__ __forceinline__ void rglru_local_unit(LAS unsigned char* lds, int unit, const bf16* PROJ, const float* WR, const float* WI, const float* BR, const float* BI,
                                                 const float* WCONV, const float* BCONV, const float* SP, float* HL, float* PC, float* AGGP, float* AGGH) {
    const int tid = threadIdx.x, lane = tid & 63, w = __builtin_amdgcn_readfirstlane(tid >> 6), c16 = lane & 15, q = lane >> 4;
    const int n = unit & 15, tg = unit >> 4;
#pragma unroll 2
    for (int i = 0; i < 8; ++i) {
        const int f = tid + 512 * i, l2 = f & 63, ks = (f >> 6) & 3, eb = (f >> 8) & 7, mat = f >> 11, i2 = l2 & 15, q2 = l2 >> 4;
        const int e = 32 * (eb >> 1) + 8 * (i2 >> 2) + 4 * (eb & 1) + (i2 & 3);
        const float* src = (mat ? WI : WR) + ((size_t)n * 128 + 32 * ks + 8 * q2) * 128 + e;
        v4u o; o.x = cvtpk(src[0], src[128]); o.y = cvtpk(src[256], src[384]); o.z = cvtpk(src[512], src[640]); o.w = cvtpk(src[768], src[896]);
        *(LAS v4u*)(lds + (size_t)f * 16) = o;
    }
    __syncthreads();
    const int token0 = tg * 512 + w * 64, gc = token0 >> 6;
    LAS f32x2v* cst = (LAS f32x2v*)(lds + 65536 + w * 1024) + q * 32;
#pragma unroll
    for (int i = 0; i < 32; ++i) if (c16 == 15) cst[i] = (f32x2v){1.0f, 0.0f};
#pragma unroll 1
    for (int tb = 0; tb < 4; ++tb) {
        const int tok = token0 + 16 * tb + c16, s = tok & (SEQ - 1);
        int zo = 0; asm volatile("" : "+v"(zo));
        const float* BCONV_ = BCONV + zo; const float* WCONV_ = WCONV + zo; const float* BR_ = BR + zo; const float* BI_ = BI + zo; const float* SP_ = SP + zo;
        float xc[4][8]; bf16x8 xf[4];
#pragma unroll
        for (int ks = 0; ks < 4; ++ks) {
            const int ch0 = n * 128 + 32 * ks + 8 * q;
            const f32x4 b0 = *(const f32x4*)(BCONV_ + ch0), b1 = *(const f32x4*)(BCONV_ + ch0 + 4);
            float a[8] = {b0.x, b0.y, b0.z, b0.w, b1.x, b1.y, b1.z, b1.w};
#pragma unroll
            for (int k = 0; k < 4; ++k) {
                v4u raw = (v4u){0u, 0u, 0u, 0u};
                if (s - 3 + k >= 0) raw = *(const v4u*)(PROJ + (size_t)(tok - 3 + k) * DIN + 6144 + ch0);
                const f32x4 w0 = *(const f32x4*)(WCONV_ + k * 2048 + ch0), w1 = *(const f32x4*)(WCONV_ + k * 2048 + ch0 + 4);
                a[0] += w0.x * bflo(raw.x); a[1] += w0.y * bfhi(raw.x); a[2] += w0.z * bflo(raw.y); a[3] += w0.w * bfhi(raw.y);
                a[4] += w1.x * bflo(raw.z); a[5] += w1.y * bfhi(raw.z); a[6] += w1.z * bflo(raw.w); a[7] += w1.w * bfhi(raw.w);
            }
#pragma unroll
            for (int j = 0; j < 8; ++j) xc[ks][j] = a[j];
            v4u pk; pk.x = cvtpk(a[0], a[1]); pk.y = cvtpk(a[2], a[3]); pk.z = cvtpk(a[4], a[5]); pk.w = cvtpk(a[6], a[7]);
            xf[ks] = __builtin_bit_cast(bf16x8, pk);
        }
#pragma unroll
        for (int ebh = 0; ebh < 2; ++ebh) {
            f32x4 ar[4], ai[4];
#pragma unroll
            for (int e4 = 0; e4 < 4; ++e4) { ar[e4] = (f32x4){0.f, 0.f, 0.f, 0.f}; ai[e4] = (f32x4){0.f, 0.f, 0.f, 0.f}; }
#pragma unroll
            for (int e4 = 0; e4 < 4; ++e4)
#pragma unroll
                for (int ks = 0; ks < 4; ++ks) { const int eb = 4 * ebh + e4;
                    const bf16x8 wfr = *(const LAS bf16x8*)(lds + (size_t)(((0 * 8 + eb) * 4 + ks) * 64 + lane) * 16);
                    const bf16x8 wfi = *(const LAS bf16x8*)(lds + (size_t)(((1 * 8 + eb) * 4 + ks) * 64 + lane) * 16);
                    ar[e4] = __builtin_amdgcn_mfma_f32_16x16x32_bf16(wfr, xf[ks], ar[e4], 0, 0, 0);
                    ai[e4] = __builtin_amdgcn_mfma_f32_16x16x32_bf16(wfi, xf[ks], ai[e4], 0, 0, 0); }
#pragma unroll
            for (int e4 = 0; e4 < 4; ++e4) { const int eb = 4 * ebh + e4, ksx = eb >> 1, jj0 = 4 * (eb & 1), ch = n * 128 + 32 * ksx + 8 * q + jj0;
                const f32x4 br = *(const f32x4*)(BR_ + ch), bi = *(const f32x4*)(BI_ + ch), sp = *(const f32x4*)(SP_ + ch);
                f32x4 hv, pv;
#pragma unroll
                for (int j = 0; j < 4; ++j) {
                    const float r = sigmoidf_(ar[e4][j] + br[j]), ig = sigmoidf_(ai[e4][j] + bi[j]);
                    const float la = -8.0f * r * sp[j];
                    float a = fexp2(la * LOG2E);
                    const float x2 = 2.0f * la;
                    float pm = 1.0f / 720.0f; pm = pm * x2 + 1.0f / 120.0f; pm = pm * x2 + 1.0f / 24.0f; pm = pm * x2 + 1.0f / 6.0f; pm = pm * x2 + 0.5f; pm = pm * x2 + 1.0f; pm = pm * x2;
                    const float m2 = (x2 > -0.25f) ? -pm : (1.0f - a * a);
                    float b = sqrtf(fmaxf(m2, 1e-12f)) * (ig * xc[ksx][jj0 + j]);
                    { const float ap = dpp_f<0x111>(1.0f, a), bp = dpp_f<0x111>(0.0f, b); b = a * bp + b; a = a * ap; }
                    { const float ap = dpp_f<0x112>(1.0f, a), bp = dpp_f<0x112>(0.0f, b); b = a * bp + b; a = a * ap; }
                    { const float ap = dpp_f<0x114>(1.0f, a), bp = dpp_f<0x114>(0.0f, b); b = a * bp + b; a = a * ap; }
                    { const float ap = dpp_f<0x118>(1.0f, a), bp = dpp_f<0x118>(0.0f, b); b = a * bp + b; a = a * ap; }
                    const int ci = eb * 4 + j;
                    const f32x2v cr = cst[ci];
                    const float P = a * cr.x, H = b + a * cr.y;
                    pv[j] = P; hv[j] = H;
                    if (c16 == 15) cst[ci] = (f32x2v){P, H};
                }
                const size_t di = ((((size_t)gc * 16 + n) * 4 + tb) * 8 + eb) * 64 + lane;
                { v4u o; o.x = cvtpk(hv[0], hv[1]); o.y = cvtpk(hv[2], hv[3]); o.z = cvtpk(pv[0], pv[1]); o.w = cvtpk(pv[2], pv[3]); __builtin_nontemporal_store(o, (v4u*)HL + di); }
                if (tb == 3 && c16 == 15) { *(f32x4*)(AGGP + (size_t)gc * 2048 + ch) = pv; *(f32x4*)(AGGH + (size_t)gc * 2048 + ch) = hv; }
            }
        }
    }
    __syncthreads();
}

__device__ __forceinline__ void rglru_final_unit(int unit, const bf16* PROJ, const float* HL, const float* PC, const float* AGGP, const float* AGGH, const float* GOB, bf16* Y, float* SSB) {
    const int tid = threadIdx.x, lane = tid & 63, w = __builtin_amdgcn_readfirstlane(tid >> 6), c16 = lane & 15, q = lane >> 4;
    const int n = unit & 15, tg = unit >> 4;
    const int token0 = tg * 512 + w * 64, gc = token0 >> 6, cin = gc & 31, gb = gc - cin;
    float carry[32];
#pragma unroll
    for (int eb = 0; eb < 8; ++eb) { const int ch = n * 128 + 32 * (eb >> 1) + 8 * q + 4 * (eb & 1);
        f32x4 p0 = (f32x4){1.f, 1.f, 1.f, 1.f}, h0 = (f32x4){0.f, 0.f, 0.f, 0.f}, p1 = p0, h1 = h0;
        if (2 * c16 < cin) { p0 = *(const f32x4*)(AGGP + (size_t)(gb + 2 * c16) * 2048 + ch); h0 = *(const f32x4*)(AGGH + (size_t)(gb + 2 * c16) * 2048 + ch); }
        if (2 * c16 + 1 < cin) { p1 = *(const f32x4*)(AGGP + (size_t)(gb + 2 * c16 + 1) * 2048 + ch); h1 = *(const f32x4*)(AGGH + (size_t)(gb + 2 * c16 + 1) * 2048 + ch); }
#pragma unroll
        for (int j = 0; j < 4; ++j) {
            float a = p0[j] * p1[j], b = p1[j] * h0[j] + h1[j];
            { float ap = dpp_f<0x111>(1.0f, a), bp = dpp_f<0x111>(0.0f, b); ap = (c16 >= 1) ? ap : 1.0f; bp = (c16 >= 1) ? bp : 0.0f; b = a * bp + b; a = a * ap; }
            { float ap = dpp_f<0x112>(1.0f, a), bp = dpp_f<0x112>(0.0f, b); ap = (c16 >= 2) ? ap : 1.0f; bp = (c16 >= 2) ? bp : 0.0f; b = a * bp + b; a = a * ap; }
            { float ap = dpp_f<0x114>(1.0f, a), bp = dpp_f<0x114>(0.0f, b); ap = (c16 >= 4) ? ap : 1.0f; bp = (c16 >= 4) ? bp : 0.0f; b = a * bp + b; a = a * ap; }
            { float ap = dpp_f<0x118>(1.0f, a), bp = dpp_f<0x118>(0.0f, b); ap = (c16 >= 8) ? ap : 1.0f; bp = (c16 >= 8) ? bp : 0.0f; b = a * bp + b; a = a * ap; }
            carry[4 * eb + j] = __shfl(b, (lane & 48) | 15);
        }
    }
#pragma unroll 1
    for (int tb = 0; tb < 4; ++tb) {
        const int tok = token0 + 16 * tb + c16; float ssq = 0.f;
#pragma unroll
        for (int eb = 0; eb < 8; ++eb) { const int chl = 32 * (eb >> 1) + 8 * q + 4 * (eb & 1);
            const size_t di = ((((size_t)gc * 16 + n) * 4 + tb) * 8 + eb) * 64 + lane;
            const v4u hp = __builtin_nontemporal_load((const v4u*)HL + di); const f32x4 hv = (f32x4){bflo(hp.x), bfhi(hp.x), bflo(hp.y), bfhi(hp.y)}, pv = (f32x4){bflo(hp.z), bfhi(hp.z), bflo(hp.w), bfhi(hp.w)};
            const v2u gr = *(const v2u*)(PROJ + (size_t)tok * DIN + 4096 + n * 128 + chl);
            const float y0 = (hv[0] + pv[0] * carry[4 * eb + 0]) * bflo(gr.x), y1 = (hv[1] + pv[1] * carry[4 * eb + 1]) * bfhi(gr.x),
                        y2 = (hv[2] + pv[2] * carry[4 * eb + 2]) * bflo(gr.y), y3 = (hv[3] + pv[3] * carry[4 * eb + 3]) * bfhi(gr.y);
            ssq += (y0 * y0 + y1 * y1) + (y2 * y2 + y3 * y3);
            const f32x4 go = *(const f32x4*)(GOB + n * 128 + chl); v2u o; o.x = cvtpk(y0 * go.x, y1 * go.y); o.y = cvtpk(y2 * go.z, y3 * go.w); *(v2u*)(Y + (size_t)tok * D + 2048 + n * 128 + chl) = o; }
        ssq += __shfl_xor(ssq, 16); ssq += __shfl_xor(ssq, 32);
        if (q == 0) SSB[(size_t)tok * 16 + n] = ssq;
    }
}

#define XB_TMO      128
#define XB_XCNT(j)  (256  + 64 * (j))
#define XB_XSUB(j)  (1280 + 64 * (j))
#define XB_XGEN(j)  (2304 + 64 * (j))
#define XB_TOP      3328
#define XB_TOPGEN   3392
#define XCD_BAR_WORDS 3456
#define XB_SPIN_CAP (1u << 18)

__device__ __forceinline__ unsigned xb_ld(unsigned* p)              { return __hip_atomic_load(p, __ATOMIC_RELAXED, __HIP_MEMORY_SCOPE_AGENT); }
__device__ __forceinline__ unsigned xb_add(unsigned* p, unsigned v) { return __hip_atomic_fetch_add(p, v, __ATOMIC_RELAXED, __HIP_MEMORY_SCOPE_AGENT); }
__device__ __forceinline__ unsigned xb_xcc_id() { return (unsigned)__builtin_amdgcn_s_getreg((3 << 11) | 20) & 0xFu; }
#define XB_SPIN(cond, bar) do { unsigned _sp = 0; while (cond) { __builtin_amdgcn_s_sleep(1); \
    if ((++_sp & 255u) == 0u) { if (xb_ld(&(bar)[XB_TMO])) break; if (_sp > XB_SPIN_CAP) { atomicAdd(&(bar)[XB_TMO], 1u); break; } } } } while (0)

struct XcdBarrier {
    unsigned* bar; unsigned x;
    volatile LAS unsigned* st;
};

__device__ __forceinline__ XcdBarrier xcd_barrier_post(unsigned* bar, volatile LAS unsigned* st) {
    XcdBarrier b; b.bar = bar; b.x = xb_xcc_id(); b.st = st;
    if (threadIdx.x == 0) (void)xb_add(&bar[XB_XCNT(b.x)], 1u);
    return b;
}
__device__ __forceinline__ void xcd_barrier_complete(unsigned* bar, unsigned x, unsigned& nloc, unsigned& nx) {
    const unsigned G = gridDim.x * gridDim.y * gridDim.z;
    unsigned sum, cnt, mine, sp = 0u;
    for (;;) {
        sum = 0u; cnt = 0u; mine = 0u;
#pragma unroll
        for (unsigned j = 0; j < 16; ++j) { const unsigned c = xb_ld(&bar[XB_XCNT(j)]); sum += c; cnt += (c > 0u) ? 1u : 0u; mine = (j == x) ? c : mine; }
        if (sum == G) break;
        __builtin_amdgcn_s_sleep(1);
        if ((++sp & 255u) == 0u) { if (xb_ld(&bar[XB_TMO])) break; if (sp > XB_SPIN_CAP) { atomicAdd(&bar[XB_TMO], 1u); break; } }
    }
    nloc = mine > 0u ? mine : 1u; nx = cnt > 0u ? cnt : 1u;
}

__device__ __forceinline__ void xcd_barrier(const XcdBarrier& b) {
    asm volatile("s_waitcnt vmcnt(0)" ::: "memory");
    __syncthreads();
    if (threadIdx.x == 0) {
        unsigned* bar = b.bar;
        __builtin_amdgcn_s_waitcnt(0);
        unsigned nloc = b.st[0], nx = b.st[1];
        if (nloc == 0u) { xcd_barrier_complete(bar, b.x, nloc, nx); b.st[0] = nloc; b.st[1] = nx; }
        const unsigned old = xb_add(&bar[XB_XSUB(b.x)], 1u);
        const unsigned gen = old / nloc;
        if (old + 1u == (gen + 1u) * nloc) {
            __builtin_amdgcn_fence(__ATOMIC_RELEASE, "agent");
            asm volatile("s_waitcnt vmcnt(0)" ::: "memory");
            const unsigned og = xb_add(&bar[XB_TOP], 1u);
            const unsigned tg = og / nx;
            if (og + 1u == (tg + 1u) * nx) xb_add(&bar[XB_TOPGEN], 1u);
            else XB_SPIN(xb_ld(&bar[XB_TOPGEN]) == tg, bar);
            __builtin_amdgcn_fence(__ATOMIC_ACQUIRE, "agent");
            xb_add(&bar[XB_XGEN(b.x)], 1u);
            asm volatile("s_waitcnt vmcnt(0)" ::: "memory");
        } else {
            XB_SPIN(xb_ld(&bar[XB_XGEN(b.x)]) == gen, bar);
            __builtin_amdgcn_fence(__ATOMIC_ACQUIRE, "agent");
            asm volatile("s_waitcnt vmcnt(0)" ::: "memory");
        }
    }
    __syncthreads();
}

struct Args { const float* in[21]; float* out; unsigned char* ws; int ph_lo, ph_hi; };
constexpr int N_PHASES = 9;

__global__ void __launch_bounds__(NWAVES * 64, 2) mk_fwd(Args args) {
    extern __shared__ __attribute__((aligned(16))) unsigned char lds_raw[];
    LAS unsigned char* lds = (LAS unsigned char*)lds_raw;
    const int tid = threadIdx.x, lane = tid & 63, wave = __builtin_amdgcn_readfirstlane(tid >> 6);
    const int G = gridDim.x, bx = blockIdx.x, gw = bx * NWAVES + wave, NGW = G * NWAVES;
    unsigned char* ws = args.ws;
    const float* x = args.in[0]; float* out = args.out;
    bf16* WinT = (bf16*)(ws + WS_WIN); bf16* WoutT = (bf16*)(ws + WS_WOUT); bf16* WfiT = (bf16*)(ws + WS_WFI); bf16* WfoT = (bf16*)(ws + WS_WFO);
    bf16* XN = (bf16*)(ws + WS_XN); bf16* PROJ = (bf16*)(ws + WS_PROJ); bf16* Y = (bf16*)(ws + WS_Y); bf16* O1 = (bf16*)(ws + WS_O1); bf16* ACT = (bf16*)(ws + WS_ACT);
    float* HL = (float*)(ws + WS_HL); float* PC = (float*)(ws + WS_PC); bf16* FB = (bf16*)(ws + WS_PC); float* SSA = (float*)(ws + WS_SSA); float* SSB = (float*)(ws + WS_SSB);
    float* SS1 = (float*)(ws + WS_SS1); float* SS2 = (float*)(ws + WS_SS2); float* AGGP = (float*)(ws + WS_AGGP); float* AGGH = (float*)(ws + WS_AGGH); float* SP = (float*)(ws + WS_SP);
    const int lo = args.ph_lo, hi = args.ph_hi;
    if (hi > 1000) cg::this_grid().sync();
    volatile LAS unsigned* MISC = (volatile LAS unsigned*)(lds + MISC_OFF);
    if (tid < 64) MISC[tid] = 0u;
    __syncthreads();
    XcdBarrier bar; bar.bar = (unsigned*)(ws + WS_CTL); bar.x = 0; bar.st = nullptr;
    if (hi - lo > 1) bar = xcd_barrier_post((unsigned*)(ws + WS_CTL), MISC);
#ifndef PH_MASK
#define PH_MASK 0x1ff
#endif
#define IN(k) (((PH_MASK >> (k)) & 1) && lo <= (k) && (k) < hi)
#ifndef PROBE_DUP
#define PROBE_DUP 0
#endif
#ifndef PROBE_SYNC
#define PROBE_SYNC 1
#endif
#define NREP(k) (1 + ((PROBE_DUP >> (k)) & 1))
#define SEAM(k) do { if (IN(k) && IN((k) + 1)) { for (int r_ = 0; r_ < PROBE_SYNC; ++r_) xcd_barrier(bar); } } while (0)

    LAS float* scr = (LAS float*)(lds + wave * 16640);
    constexpr int I_IN = (D / 64) * (DIN / 64), I_OUT = (D / 64) * (D / 64), I_FI = (D / 64) * (2 * DFF / 64), I_FO = (DFF / 64) * (D / 64), NITEMS = I_IN + I_OUT + I_FI + I_FO;
    constexpr int CONV_WG_ITEMS = (I_OUT + I_FI) / 32;
    constexpr int CONV2_WG_ITEMS = I_FO / 32;
    static_assert((I_OUT + I_FI) % 32 == 0 && I_FO % 32 == 0, "deferred conversion items");
#define P0_DECODE(it_, src_, dst_, N_, K_) do { int r_ = (it_); \
            if (r_ < I_IN) { const int kb = r_ / (DIN / 64), nb = r_ % (DIN / 64); N_ = DIN; K_ = D; src_ = args.in[2] + (size_t)(64 * kb) * DIN + 64 * nb; dst_ = WinT + (size_t)(64 * nb) * D + 64 * kb; } \
            else if ((r_ -= I_IN) < I_OUT) { const int kb = r_ / (D / 64), nb = r_ % (D / 64); N_ = D; K_ = D; src_ = args.in[15] + (size_t)(64 * kb) * D + 64 * nb; dst_ = WoutT + (size_t)(64 * nb) * D + 64 * kb; } \
            else if ((r_ -= I_OUT) < I_FI) { const int kb = r_ / (2 * DFF / 64), nb = r_ % (2 * DFF / 64), n0d = 64 * nb, pn = n0d >> 8, within = n0d & 255; const int n0s = (within < 128 ? 0 : DFF) + 128 * pn + (within & 127); \
                N_ = 2 * DFF; K_ = D; src_ = args.in[18] + (size_t)(64 * kb) * (2 * DFF) + n0s; dst_ = WfiT + (size_t)n0d * D + 64 * kb; } \
            else { r_ -= I_FI; const int kb = r_ / (D / 64), nb = r_ % (D / 64); N_ = D; K_ = DFF; src_ = args.in[19] + (size_t)(64 * kb) * D + 64 * nb; dst_ = WfoT + (size_t)(64 * nb) * DFF + 64 * kb; } } while (0)
#define CONVERT_RANGE(first_, end_, stride_, nt_) do { \
            f32x4 nxt[16]; const float* src = nullptr; bf16* dst = nullptr; size_t N = 0, K = 0; \
            int it = (first_); bool have = it < (end_); \
            if (have) { P0_DECODE(it, src, dst, N, K); p0_load_item(nxt, src, N, lane); } \
            while (have) { \
                f32x4 cur[16]; \
                _Pragma("unroll") for (int i = 0; i < 16; ++i) cur[i] = nxt[i]; \
                bf16* cdst = dst; const size_t cK = K; \
                it += (stride_); have = it < (end_); \
                if (have) { P0_DECODE(it, src, dst, N, K); p0_load_item(nxt, src, N, lane); } \
                p0_store_item<nt_>(cur, cdst, cK, scr, lane); \
            } } while (0)
#define WG_FETCH(ctr_, out_) do { __syncthreads(); if (tid == 0) MISC[16] = __hip_atomic_fetch_add((ctr_), 1u, __ATOMIC_RELAXED, __HIP_MEMORY_SCOPE_AGENT); __syncthreads(); out_ = (int)MISC[16]; } while (0)

    if (IN(0)) for (int rep = 0; rep < NREP(0); ++rep) {
        CONVERT_RANGE(gw, I_IN, NGW, false);
        for (int m = gw; m < M; m += NGW) rms_row_to_bf16(x + (size_t)m * D, args.in[1], XN + (size_t)m * D, lane);
        for (int i = bx * 512 + tid; i < 2048; i += G * 512) SP[i] = log1pf(expf(-args.in[12][i]));
    }
    SEAM(0);
    if (IN(1)) for (int rep = 0; rep < NREP(1); ++rep) {
        pg8::Gemm g{XN, WinT, M, DIN, D}; pg8::StaticOrder S; S.init(M, DIN, G, bx);
        pg8::EpiProj E{PROJ};
        pg8::gemm_phase<pg8::EpiProj, pg8::StaticOrder, false, true>(lds, g, S, E);
    }
    SEAM(1);
    if (IN(2)) for (int rep = 0; rep < NREP(2); ++rep) {
        unsigned* qmix = (unsigned*)(ws + WS_CTL) + 8192 + 256 * rep; unsigned* qconv = qmix + 64;
        const bool conv_first = ((bx >> 3) & 7) >= 3;
        for (int pass = 0; pass < 2; ++pass) {
            if ((pass == 0) == conv_first) {
                for (;;) { int ci; WG_FETCH(qconv, ci); if (ci >= CONV_WG_ITEMS) break;
                    const int first = I_IN + ci * 32 + wave; CONVERT_RANGE(first, I_IN + ci * 32 + 32, 8, true); }
            } else {
                for (;;) { int u; WG_FETCH(qmix, u); if (u >= 1280) break;
                    if (u < 256) rglru_local_unit(lds, u, PROJ, args.in[8], args.in[10], args.in[9], args.in[11], args.in[6], args.in[7], SP, HL, PC, AGGP, AGGH);
                    else gmlp_unit(lds, u - 256, PROJ, args.in[4], args.in[5], args.in[3], args.in[13], Y, SSA); }
            }
        }
        __syncthreads();
    }
    SEAM(2);
    if (IN(3)) for (int rep = 0; rep < NREP(3); ++rep) {
        for (int u = bx; u < 256; u += G) rglru_final_unit(u, PROJ, HL, PC, AGGP, AGGH, args.in[14], Y, SSB);
    }
    SEAM(3);
    if (IN(4)) for (int rep = 0; rep < NREP(4); ++rep) {
        pg8::Gemm g{Y, WoutT, M, D, D}; pg8::StaticOrder S; S.init(M, D, G, bx);
        { pg8::Unit u;
          for (int i = 0; i < 8 && S.next(i, u); ++i) {
              if (tid < 256) { const int row = u.pm * 256 + tid; const f32x4* pa = (const f32x4*)(SSA + (size_t)row * 16); const f32x4* pb = (const f32x4*)(SSB + (size_t)row * 16);
                  float sa = 0.f, sb = 0.f;
#pragma unroll
                  for (int j = 0; j < 4; ++j) { const f32x4 a = pa[j], b = pb[j]; sa += (a.x + a.y) + (a.z + a.w); sb += (b.x + b.y) + (b.z + b.w); }
                  const float rsa = 1.0f / sqrtf(sa * (1.0f / DA) + EPS), rsb = 1.0f / sqrtf(sb * (1.0f / DA) + EPS);
                  *(LAS f32x2v*)(lds + RSL_OFF + (size_t)(i * 256 + tid) * 8) = (f32x2v){rsa / rsb, rsb}; } }
          __syncthreads(); }
        pg8::EpiRows<true> E{O1, SS1, lds + RSL_OFF};
        pg8::gemm_phase<pg8::EpiRows<true>, pg8::StaticOrder, false, true>(lds, g, S, E);
    }
    SEAM(4);
    if (IN(5)) for (int rep = 0; rep < NREP(5); ++rep) {
        for (int row = gw; row < M; row += NGW) {
            const float rs1 = 1.0f / sqrtf(wave_sum(SS1[(size_t)row * 64 + lane]) * (1.0f / D) + EPS);
            f32x4 x1[16]; float s2 = 0.f;
#pragma unroll
            for (int j = 0; j < 16; ++j) { const int col = 4 * lane + 256 * j;
                const f32x4 xv = __builtin_nontemporal_load((const f32x4*)(x + (size_t)row * D + col)); const v2u o = *(const v2u*)(O1 + (size_t)row * D + col); const f32x4 g = *(const f32x4*)(args.in[16] + col);
                f32x4 v; v.x = xv.x + bflo(o.x) * rs1 * g.x; v.y = xv.y + bfhi(o.x) * rs1 * g.y; v.z = xv.z + bflo(o.y) * rs1 * g.z; v.w = xv.w + bfhi(o.y) * rs1 * g.w;
                x1[j] = v; s2 += (v.x * v.x + v.y * v.y) + (v.z * v.z + v.w * v.w); }
            const float rs2 = 1.0f / sqrtf(wave_sum(s2) * (1.0f / D) + EPS);
#pragma unroll
            for (int j = 0; j < 16; ++j) { const int col = 4 * lane + 256 * j; const f32x4 g = *(const f32x4*)(args.in[17] + col);
                v2u o; o.x = cvtpk(x1[j].x * rs2 * g.x, x1[j].y * rs2 * g.y); o.y = cvtpk(x1[j].z * rs2 * g.z, x1[j].w * rs2 * g.w);
                *(v2u*)(XN + (size_t)row * D + col) = o; }
        }
    }
    SEAM(5);
    if (IN(6)) for (int rep = 0; rep < NREP(6); ++rep) {
        pg8::Gemm g{XN, WfiT, M, 2 * DFF, D}; pg8::StaticOrder S; S.init(M, 2 * DFF, G, bx);
        pg8::EpiSwiGLU E{ACT};
        pg8::gemm_phase<pg8::EpiSwiGLU, pg8::StaticOrder, false, true>(lds, g, S, E);
        { unsigned* qconv2 = (unsigned*)(ws + WS_CTL) + 8192 + 128 + 256 * rep;
          for (;;) { int ci; WG_FETCH(qconv2, ci); if (ci >= CONV2_WG_ITEMS) break;
              const int first = I_IN + I_OUT + I_FI + ci * 32 + wave; CONVERT_RANGE(first, I_IN + I_OUT + I_FI + ci * 32 + 32, 8, true); }
          __syncthreads(); }
    }
    SEAM(6);
    if (IN(7)) for (int rep = 0; rep < NREP(7); ++rep) {
        pg8::Gemm g{ACT, WfoT, M, D, DFF}; pg8::StaticOrder S; S.init(M, D, G, bx);
        pg8::EpiRows<false> E{FB, SS2, lds + RSL_OFF};
        pg8::gemm_phase<pg8::EpiRows<false>, pg8::StaticOrder, false, true>(lds, g, S, E);
    }
    SEAM(7);
    if (IN(8)) for (int rep = 0; rep < NREP(8); ++rep) {
        float* dst = (rep + 1 == NREP(8)) ? out : (float*)(ws + WS_HL);
        for (int row = gw; row < M; row += NGW) {
            const float rs = 1.0f / sqrtf(wave_sum(SS2[(size_t)row * 64 + lane]) * (1.0f / D) + EPS);
            const float rs1 = 1.0f / sqrtf(wave_sum(SS1[(size_t)row * 64 + lane]) * (1.0f / D) + EPS);
#pragma unroll
            for (int j = 0; j < 16; ++j) { const int col = 4 * lane + 256 * j;
                const f32x4 xv = __builtin_nontemporal_load((const f32x4*)(x + (size_t)row * D + col)); const v2u o1 = *(const v2u*)(O1 + (size_t)row * D + col); const f32x4 g1 = *(const f32x4*)(args.in[16] + col);
                const v2u o = *(const v2u*)(FB + (size_t)row * D + col); const f32x4 g = *(const f32x4*)(args.in[20] + col);
                f32x4 v; v.x = xv.x + bflo(o1.x) * rs1 * g1.x; v.y = xv.y + bfhi(o1.x) * rs1 * g1.y; v.z = xv.z + bflo(o1.y) * rs1 * g1.z; v.w = xv.w + bfhi(o1.y) * rs1 * g1.w;
                v.x = v.x + bflo(o.x) * rs * g.x; v.y = v.y + bfhi(o.x) * rs * g.y; v.z = v.z + bflo(o.y) * rs * g.z; v.w = v.w + bfhi(o.y) * rs * g.w;
                __builtin_nontemporal_store(v, (f32x4*)(dst + (size_t)row * D + col)); }
        }
    }
#undef IN
#undef SEAM
#undef P0_DECODE
#undef CONVERT_RANGE
#undef WG_FETCH
}

extern "C" void kernel_launch(void* const* d_in, const int* in_sizes, int n_in, void* d_out, int out_size, void* d_ws, size_t ws_size, hipStream_t stream) {
    static int grid = 0;
    if (grid == 0) {
        if (n_in != 21 || out_size != M * D || ws_size < WS_END) { fprintf(stderr, "kernel_launch: unexpected problem (n_in %d, out %d, ws %zu)\n", n_in, out_size, ws_size); grid = -1; return; }
        int dev = 0, cus = 0, per_cu = 0;
        if (hipGetDevice(&dev) != hipSuccess || hipDeviceGetAttribute(&cus, hipDeviceAttributeMultiprocessorCount, dev) != hipSuccess) { grid = -1; return; }
        if (hipFuncSetAttribute((const void*)mk_fwd, hipFuncAttributeMaxDynamicSharedMemorySize, LDS_BYTES) != hipSuccess) { fprintf(stderr, "kernel_launch: hipFuncSetAttribute failed\n"); grid = -1; return; }
        if (hipOccupancyMaxActiveBlocksPerMultiprocessor(&per_cu, (const void*)mk_fwd, NWAVES * 64, LDS_BYTES) != hipSuccess || per_cu < 1) per_cu = 1;
        (void)hipGetLastError();
        grid = cus * per_cu;
        fprintf(stderr, "kernel_launch: %d CUs x %d -> grid %d\n", cus, per_cu, grid);
    }
    if (grid < 0) return;
    if (hipMemsetAsync((char*)d_ws + WS_CTL, 0, CTL_ZERO_BYTES, stream) != hipSuccess) { fprintf(stderr, "kernel_launch: hipMemsetAsync failed\n"); return; }
    Args a{};
    for (int i = 0; i < 21; ++i) a.in[i] = (const float*)d_in[i];
    a.out = (float*)d_out; a.ws = (unsigned char*)d_ws;
#if MK_N_LAUNCHES == 1
    a.ph_lo = 0; a.ph_hi = N_PHASES;
    void* kargs[] = {&a};
    hipError_t e = hipLaunchCooperativeKernel((const void*)mk_fwd, dim3(grid), dim3(NWAVES * 64), kargs, LDS_BYTES, stream);
    if (e != hipSuccess) fprintf(stderr, "kernel_launch: cooperative launch failed: %s (grid %d)\n", hipGetErrorString(e), grid);
#else
    for (int p = 0; p < N_PHASES; ++p) { a.ph_lo = p; a.ph_hi = p + 1; hipLaunchKernelGGL(mk_fwd, dim3(grid), dim3(NWAVES * 64), LDS_BYTES, stream, a); }
#endif
}
```

```cpp
#include <hip/hip_runtime.h>
#include <hip/hip_cooperative_groups.h>
#include <cstdio>
#include <cstdint>
namespace cg = cooperative_groups;
#ifndef MK_N_LAUNCHES
#define MK_N_LAUNCHES 1
#endif
namespace pg8 {
#define PG8_LAS __attribute__((address_space(3)))
typedef unsigned short bf16_t;
typedef short bf16x8 __attribute__((ext_vector_type(8)));
typedef float f32x4 __attribute__((ext_vector_type(4)));
typedef unsigned u32x4 __attribute__((ext_vector_type(4)));
constexpr int BM = 256, BK = 64, HALF = 128, HTB = HALF * BK * 2  , STAGE_BYTES = 8 * HTB, NXCD = 8, WGM = 8;

__host__ __device__ __forceinline__ int lds_byte(int r, int c) { const int st = (r >> 4) * 2 + (c >> 5), rr = r & 15, cc = c & 31, ob = rr * 64 + cc * 2; return st * 1024 + (ob ^ (((ob >> 9) & 1) << 5)); }
__host__ __device__ __forceinline__ void stage_rc(int b, int& R, int& C) { const int st = b / 1024, sb = b % 1024, swz = sb ^ (((sb >> 9) & 1) << 5); R = (st >> 1) * 16 + swz / 64; C = (st & 1) * 32 + (swz % 64) / 2; }
__host__ __device__ __forceinline__ int perm32(int rho) { const int n = rho >> 4, i = rho & 15; return 8 * (i >> 2) + 4 * n + (i & 3); }

struct Unit { int pm, pn; };
struct Gemm { const bf16_t* A; const bf16_t* Bt; int M, N, K; };

struct StaticOrder {
    int nM, nN, nwg, G, c;
    __host__ __device__ void init(int M, int N, int G_, int c_) { nM = M / BM; nN = N / BM; nwg = nM * nN; G = G_; c = c_; }
    __host__ __device__ bool next(int i, Unit& u) const {
        const long L = (long)i * G + c; if (L >= nwg) return false;
        int wgid = (int)L; { const int q = nwg / NXCD, r = nwg % NXCD, xcd = wgid % NXCD, off = wgid / NXCD; wgid = (xcd < r ? xcd * (q + 1) : r * (q + 1) + (xcd - r) * q) + off; }
        const int nig = WGM * nN, gid = wgid / nig, fm = gid * WGM, gsz = (nM - fm) < WGM ? (nM - fm) : WGM;
        u.pm = fm + ((wgid % nig) % gsz); u.pn = (wgid % nig) / gsz; return true;
    }
    __device__ __forceinline__ void a_ready(const Unit&) const {}
    __device__ __forceinline__ void done(const Unit&) const {}
};
__device__ __forceinline__ unsigned cvt_pk_bf16(float lo, float hi) { unsigned r; asm volatile("v_cvt_pk_bf16_f32 %0, %1, %2" : "=v"(r) : "v"(lo), "v"(hi)); return r; }

template <class Epi, class Sched, bool ALIGN_EPI = false, bool SP2 = false>
__device__ __forceinline__ void gemm_phase(PG8_LAS unsigned char* lds, const Gemm g, const Sched& S, const Epi& E) {
    const int tid = threadIdx.x, wid = __builtin_amdgcn_readfirstlane(tid >> 6), lane = tid & 63, wr = wid >> 2, wc = wid & 3, fr = lane & 15, fq = lane >> 4;
    const int K = g.K, nt = K / BK;
    unsigned voffA[2], voffB[2];
#pragma unroll
    for (int i = 0; i < 2; ++i) { int R, C; stage_rc(tid * 16 + i * 8192, R, C); const int Rb = Epi::PERM ? ((R & ~31) + perm32(R & 31)) : R;
        voffA[i] = (unsigned)(R * K + C) * 2u; voffB[i] = (unsigned)(Rb * K + C) * 2u; }
    const size_t kstep = (size_t)(BK * 2);
    const size_t hstep = (size_t)HALF * K * 2;
    const size_t tstep = 2 * hstep;
    const unsigned ldsw = (unsigned)wid * 1024u;
    const int aoff = lds_byte(wr * 64 + fr, fq * 8), boff = lds_byte(wc * 32 + fr, fq * 8);
#define PG8_SA(b, h) (((b) * 2 + (h)) * HTB)
#define PG8_SB(b, h) ((4 + (b) * 2 + (h)) * HTB)
#define PG8_STAGE(bufoff, gbase, voff) do { _Pragma("unroll") for (int _i = 0; _i < 2; ++_i) \
        __builtin_amdgcn_global_load_lds((const unsigned*)((const char*)(gbase) + (voff)[_i]), (PG8_LAS unsigned*)(lds + (bufoff) + ldsw + _i * 8192), 16, 0, 0); } while (0)
#define PG8_LDA(dst, b, h) do { _Pragma("unroll") for (int m = 0; m < 4; ++m) _Pragma("unroll") for (int k = 0; k < 2; ++k) dst[m][k] = *(const PG8_LAS bf16x8*)(lds + PG8_SA(b, h) + aoff + m * 2048 + k * 1024); } while (0)
#define PG8_LDB(dst, b, h) do { _Pragma("unroll") for (int n = 0; n < 2; ++n) _Pragma("unroll") for (int k = 0; k < 2; ++k) dst[n][k] = *(const PG8_LAS bf16x8*)(lds + PG8_SB(b, h) + boff + n * 2048 + k * 1024); } while (0)
#define PG8_MMA(ai, bj, At, Bt) do { __builtin_amdgcn_s_setprio(1); _Pragma("unroll") for (int m = 0; m < 4; ++m) _Pragma("unroll") for (int n = 0; n < 2; ++n) _Pragma("unroll") for (int k = 0; k < 2; ++k) \
        acc[ai][bj][m][n] = __builtin_amdgcn_mfma_f32_16x16x32_bf16(Bt[n][k], At[m][k], acc[ai][bj][m][n], 0, 0, 0); __builtin_amdgcn_s_setprio(0); } while (0)
#define PG8_WAIT_V(n) asm volatile("s_waitcnt vmcnt(" #n ")" ::: "memory")
#define PG8_WAIT_L(n) asm volatile("s_waitcnt lgkmcnt(" #n ")" ::: "memory")
#define PG8_BAR __builtin_amdgcn_s_barrier()
#define PG8_SCHED __builtin_amdgcn_sched_barrier(0)
    Unit cur, nxt; int ui = 0;
    if (!S.next(0, cur)) return;
    f32x4 acc[2][2][4][2];
#pragma unroll
    for (int a = 0; a < 2; ++a)
#pragma unroll
        for (int b = 0; b < 2; ++b)
#pragma unroll
            for (int m = 0; m < 4; ++m)
#pragma unroll
                for (int n = 0; n < 2; ++n) acc[a][b][m][n] = (f32x4){0.f, 0.f, 0.f, 0.f};
    bf16x8 At[4][2], B0[2][2], B1[2][2];
    const char* cA = (const char*)g.A + (size_t)cur.pm * tstep; const char* cB = (const char*)g.Bt + (size_t)cur.pn * tstep;
    S.a_ready(cur);
    if constexpr (SP2) {
        PG8_STAGE(PG8_SB(0, 0), cB, voffB); PG8_STAGE(PG8_SB(0, 1), cB + hstep, voffB); PG8_STAGE(PG8_SA(0, 0), cA, voffA); PG8_STAGE(PG8_SA(0, 1), cA + hstep, voffA);
        if (wr == 1) PG8_BAR;
        PG8_WAIT_V(2); PG8_BAR;
        PG8_STAGE(PG8_SB(1, 0), cB + kstep, voffB); PG8_STAGE(PG8_SA(1, 0), cA + kstep, voffA); PG8_STAGE(PG8_SB(1, 1), cB + hstep + kstep, voffB);
        PG8_WAIT_V(6); PG8_BAR;
    } else {
        PG8_STAGE(PG8_SB(0, 0), cB, voffB); PG8_STAGE(PG8_SA(0, 0), cA, voffA); PG8_STAGE(PG8_SB(0, 1), cB + hstep, voffB); PG8_STAGE(PG8_SA(0, 1), cA + hstep, voffA);
        if (wr == 1) PG8_BAR;
        PG8_WAIT_V(4); PG8_BAR;
        PG8_STAGE(PG8_SB(1, 0), cB + kstep, voffB); PG8_STAGE(PG8_SA(1, 0), cA + kstep, voffA); PG8_STAGE(PG8_SB(1, 1), cB + hstep + kstep, voffB);
        PG8_WAIT_V(6); PG8_BAR;
    }
    for (;;) {
        const bool has_next = S.next(ui + 1, nxt);
        const char* nA = has_next ? (const char*)g.A + (size_t)nxt.pm * tstep : cA; const char* nB = has_next ? (const char*)g.Bt + (size_t)nxt.pn * tstep : cB;
        for (int t = 0; t < nt; t += 2) {
            if constexpr (Epi::MID) { if (t == (nt >> 1)) E.mid(acc, ui, wr, fr); }
            const bool last = (t == nt - 2);
            const char* a1 = cA + (size_t)(t + 1) * kstep;
            const char* a2 = last ? nA : cA + (size_t)(t + 2) * kstep; const char* b2 = last ? nB : cB + (size_t)(t + 2) * kstep;
            const char* a3 = a2 + kstep; const char* b3 = b2 + kstep;
            if (last && has_next) S.a_ready(nxt);
            if constexpr (SP2) {
            PG8_LDB(B0, 0, 0); PG8_LDB(B1, 0, 1); PG8_SCHED; PG8_LDA(At, 0, 0); PG8_STAGE(PG8_SA(1, 1), a1 + hstep, voffA);
            PG8_WAIT_V(8); PG8_WAIT_L(0); PG8_BAR; PG8_MMA(0, 0, At, B0); PG8_MMA(0, 1, At, B1); PG8_BAR; PG8_SCHED;
            PG8_LDA(At, 0, 1); PG8_STAGE(PG8_SB(0, 0), b2, voffB); PG8_STAGE(PG8_SB(0, 1), b2 + hstep, voffB); PG8_STAGE(PG8_SA(0, 0), a2, voffA);
            PG8_WAIT_V(8); PG8_WAIT_L(0); PG8_BAR; PG8_MMA(1, 0, At, B0); PG8_MMA(1, 1, At, B1); PG8_BAR; PG8_SCHED;
            PG8_LDB(B0, 1, 0); PG8_LDB(B1, 1, 1); PG8_SCHED; PG8_LDA(At, 1, 0); PG8_STAGE(PG8_SA(0, 1), a2 + hstep, voffA);
            PG8_WAIT_V(8); PG8_WAIT_L(0); PG8_BAR; PG8_MMA(0, 0, At, B0); PG8_MMA(0, 1, At, B1); PG8_BAR; PG8_SCHED;
            PG8_LDA(At, 1, 1); PG8_STAGE(PG8_SB(1, 0), b3, voffB); PG8_STAGE(PG8_SB(1, 1), b3 + hstep, voffB); PG8_STAGE(PG8_SA(1, 0), a3, voffA);
            PG8_WAIT_V(8); PG8_WAIT_L(0); PG8_BAR; PG8_MMA(1, 0, At, B0); PG8_MMA(1, 1, At, B1); PG8_BAR; PG8_SCHED;
            } else {
            PG8_LDB(B0, 0, 0); PG8_SCHED; PG8_LDA(At, 0, 0); PG8_STAGE(PG8_SA(1, 1), a1 + hstep, voffA);
            PG8_WAIT_L(8); PG8_BAR; PG8_WAIT_L(0); PG8_MMA(0, 0, At, B0); PG8_BAR; PG8_SCHED;
            PG8_LDB(B1, 0, 1); PG8_STAGE(PG8_SB(0, 0), b2, voffB);
            PG8_BAR; PG8_WAIT_L(0); PG8_MMA(0, 1, At, B1); PG8_BAR;
            PG8_LDA(At, 0, 1); PG8_STAGE(PG8_SA(0, 0), a2, voffA);
            PG8_BAR; PG8_WAIT_L(0); PG8_MMA(1, 0, At, B0); PG8_BAR; PG8_SCHED;
            PG8_STAGE(PG8_SB(0, 1), b2 + hstep, voffB);
            PG8_WAIT_V(6); PG8_BAR; PG8_MMA(1, 1, At, B1); PG8_BAR;
            PG8_LDB(B0, 1, 0); PG8_SCHED; PG8_LDA(At, 1, 0); PG8_STAGE(PG8_SA(0, 1), a2 + hstep, voffA);
            PG8_WAIT_L(8); PG8_BAR; PG8_WAIT_L(0); PG8_MMA(0, 0, At, B0); PG8_BAR; PG8_SCHED;
            PG8_LDB(B1, 1, 1); PG8_STAGE(PG8_SB(1, 0), b3, voffB);
            PG8_BAR; PG8_WAIT_L(0); PG8_MMA(0, 1, At, B1); PG8_BAR;
            PG8_LDA(At, 1, 1); PG8_STAGE(PG8_SA(1, 0), a3, voffA);
            PG8_BAR; PG8_WAIT_L(0); PG8_MMA(1, 0, At, B0); PG8_BAR; PG8_SCHED;
            PG8_STAGE(PG8_SB(1, 1), b3 + hstep, voffB);
            PG8_WAIT_V(6); PG8_BAR; PG8_MMA(1, 1, At, B1); PG8_BAR;
            }
        }
        if constexpr (ALIGN_EPI) { if (wr == 0) PG8_BAR; }
        if constexpr (!Epi::AFTER_DRAIN) { E(acc, cur, ui, wr, wc, fr, fq); S.done(cur); }
        if (!has_next) break;
#pragma unroll
        for (int a = 0; a < 2; ++a)
#pragma unroll
            for (int b = 0; b < 2; ++b)
#pragma unroll
                for (int m = 0; m < 4; ++m)
#pragma unroll
                    for (int n = 0; n < 2; ++n) acc[a][b][m][n] = (f32x4){0.f, 0.f, 0.f, 0.f};
        cur = nxt; cA = nA; cB = nB; ++ui;
        if constexpr (ALIGN_EPI) { if (wr == 1) PG8_BAR; }
    }
    PG8_WAIT_V(0);
    if constexpr (!ALIGN_EPI) { if (wr == 0) PG8_BAR; }
    PG8_BAR;
#undef PG8_SA
#undef PG8_SB
#undef PG8_STAGE
#undef PG8_LDA
#undef PG8_LDB
#undef PG8_MMA
#undef PG8_WAIT_V
#undef PG8_WAIT_L
#undef PG8_BAR
#undef PG8_SCHED
}
}

#define LAS __attribute__((address_space(3)))
typedef unsigned short bf16;
typedef unsigned v4u __attribute__((ext_vector_type(4)));
typedef unsigned v2u __attribute__((ext_vector_type(2)));
typedef float f32x4 __attribute__((ext_vector_type(4)));
typedef float f32x2v __attribute__((ext_vector_type(2)));
typedef short bf16x8 __attribute__((ext_vector_type(8)));

constexpr int NWAVES = 8;
constexpr int M = 8192, D = 4096, DIN = 8192, DA = 2048, DFF = 11008, SEQ = 2048;
constexpr float EPS = 1e-6f, LOG2E = 1.4426950408889634f;
constexpr size_t MiB = 1u << 20;
constexpr size_t WS_WIN = 0, WS_WOUT = 64 * MiB, WS_WFI = 96 * MiB, WS_WFO = 268 * MiB, WS_XN = 354 * MiB, WS_PROJ = 418 * MiB, WS_Y = 546 * MiB,
                 WS_HL = 610 * MiB, WS_PC = 674 * MiB, WS_O1 = 738 * MiB, WS_ACT = 802 * MiB, WS_SSA = 974 * MiB, WS_SSB = WS_SSA + 512 * 1024,
                 WS_SS1 = 975 * MiB, WS_SS2 = 977 * MiB, WS_AGGP = 979 * MiB, WS_AGGH = 980 * MiB, WS_SP = 981 * MiB, WS_CTL = 982 * MiB, WS_END = 983 * MiB;
constexpr size_t CTL_ZERO_BYTES = 65536;
constexpr int RING_BYTES = 131072, RSL_OFF = RING_BYTES, MISC_OFF = RING_BYTES + 16384, LDS_BYTES = MISC_OFF + 256;

#define LDS_WAIT() asm volatile("s_waitcnt lgkmcnt(0)" ::: "memory")
__device__ __forceinline__ unsigned cvtpk(float lo, float hi) { return pg8::cvt_pk_bf16(lo, hi); }
__device__ __forceinline__ float bflo(unsigned w) { return __builtin_bit_cast(float, w << 16); }
__device__ __forceinline__ float bfhi(unsigned w) { return __builtin_bit_cast(float, w & 0xffff0000u); }
__device__ __forceinline__ float wave_sum(float v) {
#pragma unroll
    for (int o = 1; o < 64; o <<= 1) v += __shfl_xor(v, o);
    return v;
}
__device__ __forceinline__ float fexp2(float x) { return __builtin_amdgcn_exp2f(x); }
__device__ __forceinline__ float frcp(float x) { return __builtin_amdgcn_rcpf(x); }
__device__ __forceinline__ float gelu_tanh(float x) { const float z = x * (1.0f + 0.044715f * x * x); return x * frcp(1.0f + fexp2(-2.302208198f * z)); }
__device__ __forceinline__ float sigmoidf_(float x) { return frcp(1.0f + fexp2(-LOG2E * x)); }
template <int CTRL> __device__ __forceinline__ float dpp_f(float old, float src) {
    return __builtin_bit_cast(float, __builtin_amdgcn_update_dpp(__builtin_bit_cast(int, old), __builtin_bit_cast(int, src), CTRL, 0xf, 0xf, false));
}

namespace pg8 {
struct EpiProj {
    static constexpr bool PERM = true, AFTER_DRAIN = false, MID = false;
    bf16_t* O;
    __device__ __forceinline__ void mid(f32x4 (&)[2][2][4][2], int, int, int) const {}
    __device__ __forceinline__ void operator()(const f32x4 (&acc)[2][2][4][2], const Unit& u, int ui, int wr, int wc, int fr, int fq) const {
        const bool act = u.pn < 24;
        const int row0 = u.pm * BM + wr * 64 + fr, col0 = u.pn * BM + wc * 32 + 8 * fq;
#pragma unroll
        for (int ai = 0; ai < 2; ++ai)
#pragma unroll
            for (int m = 0; m < 4; ++m) { bf16_t* rowp = O + (size_t)(row0 + ai * HALF + m * 16) * DIN + col0;
#pragma unroll
                for (int bj = 0; bj < 2; ++bj) { f32x4 v0 = acc[ai][bj][m][0], v1 = acc[ai][bj][m][1];
                    if (act) {
#pragma unroll
                        for (int j = 0; j < 4; ++j) { v0[j] = gelu_tanh(v0[j]); v1[j] = gelu_tanh(v1[j]); } }
                    u32x4 w; w.x = cvt_pk_bf16(v0[0], v0[1]); w.y = cvt_pk_bf16(v0[2], v0[3]); w.z = cvt_pk_bf16(v1[0], v1[1]); w.w = cvt_pk_bf16(v1[2], v1[3]);
                    *(u32x4*)(rowp + bj * HALF) = w; } }
    }
};
template <bool SCALE> struct EpiRows {
    static constexpr bool PERM = true, AFTER_DRAIN = false, MID = SCALE;
    bf16_t* O; float* SS; PG8_LAS unsigned char* rsl;
    __device__ __forceinline__ void mid(f32x4 (&acc)[2][2][4][2], int ui, int wr, int fr) const {
        typedef float f2 __attribute__((ext_vector_type(2)));
#pragma unroll
        for (int ai = 0; ai < 2; ++ai)
#pragma unroll
            for (int m = 0; m < 4; ++m) { const int rl = ai * HALF + wr * 64 + m * 16 + fr; const f2 s = *(const PG8_LAS f2*)(rsl + (size_t)(ui * 256 + rl) * 8);
#pragma unroll
                for (int bj = 0; bj < 2; ++bj)
#pragma unroll
                    for (int n = 0; n < 2; ++n) acc[ai][bj][m][n] = acc[ai][bj][m][n] * s.x; }
    }
    __device__ __forceinline__ void operator()(const f32x4 (&acc)[2][2][4][2], const Unit& u, int ui, int wr, int wc, int fr, int fq) const {
        typedef float f2 __attribute__((ext_vector_type(2)));
        const int row0 = u.pm * BM + wr * 64 + fr, col0 = u.pn * BM + wc * 32 + 8 * fq;
#pragma unroll
        for (int ai = 0; ai < 2; ++ai)
#pragma unroll
            for (int m = 0; m < 4; ++m) { const int rl = ai * HALF + wr * 64 + m * 16 + fr; const int row = u.pm * BM + rl;
                float sc = 1.0f; if (SCALE) { const f2 s = *(const PG8_LAS f2*)(rsl + (size_t)(ui * 256 + rl) * 8); sc = s.y; }
                bf16_t* rowp = O + (size_t)row * 4096 + col0; float ss = 0.f;
#pragma unroll
                for (int bj = 0; bj < 2; ++bj) { const f32x4 v0 = acc[ai][bj][m][0] * sc, v1 = acc[ai][bj][m][1] * sc;
                    ss += (v0[0] * v0[0] + v0[1] * v0[1]) + (v0[2] * v0[2] + v0[3] * v0[3]) + (v1[0] * v1[0] + v1[1] * v1[1]) + (v1[2] * v1[2] + v1[3] * v1[3]);
                    u32x4 w; w.x = cvt_pk_bf16(v0[0], v0[1]); w.y = cvt_pk_bf16(v0[2], v0[3]); w.z = cvt_pk_bf16(v1[0], v1[1]); w.w = cvt_pk_bf16(v1[2], v1[3]);
                    *(u32x4*)(rowp + bj * HALF) = w; }
                ss += __shfl_xor(ss, 16); ss += __shfl_xor(ss, 32);
                if (fq == 0) SS[(size_t)row * 64 + u.pn * 4 + wc] = ss; }
    }
};
struct EpiSwiGLU {
    static constexpr bool PERM = true, AFTER_DRAIN = false, MID = false;
    bf16_t* O;
    __device__ __forceinline__ void mid(f32x4 (&)[2][2][4][2], int, int, int) const {}
    __device__ __forceinline__ void operator()(const f32x4 (&acc)[2][2][4][2], const Unit& u, int ui, int wr, int wc, int fr, int fq) const {
        const int row0 = u.pm * BM + wr * 64 + fr, col0 = u.pn * HALF + wc * 32 + 8 * fq;
#pragma unroll
        for (int ai = 0; ai < 2; ++ai)
#pragma unroll
            for (int m = 0; m < 4; ++m) { bf16_t* rowp = O + (size_t)(row0 + ai * HALF + m * 16) * 11008 + col0;
                f32x4 v0, v1;
#pragma unroll
                for (int j = 0; j < 4; ++j) { const float g0 = acc[ai][0][m][0][j], g1 = acc[ai][0][m][1][j];
                    v0[j] = g0 * __builtin_amdgcn_rcpf(1.0f + __builtin_amdgcn_exp2f(-1.4426950408889634f * g0)) * acc[ai][1][m][0][j];
                    v1[j] = g1 * __builtin_amdgcn_rcpf(1.0f + __builtin_amdgcn_exp2f(-1.4426950408889634f * g1)) * acc[ai][1][m][1][j]; }
                u32x4 w; w.x = cvt_pk_bf16(v0[0], v0[1]); w.y = cvt_pk_bf16(v0[2], v0[3]); w.z = cvt_pk_bf16(v1[0], v1[1]); w.w = cvt_pk_bf16(v1[2], v1[3]);
                *(u32x4*)rowp = w; }
    }
};
}

__device__ __forceinline__ void p0_load_item(f32x4 (&v)[16], const float* src, size_t N, int lane) {
    const float* p = src + (size_t)(lane >> 4) * N + 4 * (lane & 15);
#pragma unroll
    for (int i = 0; i < 16; ++i) v[i] = __builtin_nontemporal_load((const f32x4*)(p + (size_t)(4 * i) * N));
}
template <bool NT> __device__ __forceinline__ void p0_store_item(const f32x4 (&v)[16], bf16* dst, size_t K, LAS float* scr, int lane) {
    const int r = lane >> 4, c = lane & 15;
#pragma unroll
    for (int i = 0; i < 16; ++i) { LAS float* s = scr + (4 * i + r) * 65 + 4 * c; s[0] = v[i].x; s[1] = v[i].y; s[2] = v[i].z; s[3] = v[i].w; }
    LDS_WAIT(); asm volatile("" ::: "memory");
    const int c8 = lane & 7;
#pragma unroll
    for (int j = 0; j < 8; ++j) { const int n = (lane >> 3) + 8 * j; const LAS float* s = scr + (8 * c8) * 65 + n;
        v4u o; o.x = cvtpk(s[0 * 65], s[1 * 65]); o.y = cvtpk(s[2 * 65], s[3 * 65]); o.z = cvtpk(s[4 * 65], s[5 * 65]); o.w = cvtpk(s[6 * 65], s[7 * 65]);
        if (NT) __builtin_nontemporal_store(o, (v4u*)(dst + (size_t)n * K + 8 * c8)); else *(v4u*)(dst + (size_t)n * K + 8 * c8) = o; }
    LDS_WAIT(); asm volatile("" ::: "memory");
}
__device__ __forceinline__ void rms_row_to_bf16(const float* xrow, const float* g, bf16* orow, int lane) {
    const f32x4* xr = (const f32x4*)xrow + lane;
    f32x4 v[16]; float s = 0.f;
#pragma unroll
    for (int j = 0; j < 16; ++j) { v[j] = __builtin_nontemporal_load(xr + 64 * j); s += (v[j].x * v[j].x + v[j].y * v[j].y) + (v[j].z * v[j].z + v[j].w * v[j].w); }
    const float rs = 1.0f / sqrtf(wave_sum(s) * (1.0f / D) + EPS);
    v2u* o8 = (v2u*)orow + lane; const f32x4* gp = (const f32x4*)g + lane;
#pragma unroll
    for (int j = 0; j < 16; ++j) { const f32x4 gg = gp[64 * j]; v2u o; o.x = cvtpk(v[j].x * rs * gg.x, v[j].y * rs * gg.y); o.y = cvtpk(v[j].z * rs * gg.z, v[j].w * rs * gg.w); o8[64 * j] = o; }
}

__device__ __forceinline__ void gmlp_unit(LAS unsigned char* lds, int unit, const bf16* PROJ, const float* WSP, const float* BSP, const float* GV, const float* GOA, bf16* Y, float* SSA) {
    const int tid = threadIdx.x, lane = tid & 63, w = __builtin_amdgcn_readfirstlane(tid >> 6), c16 = lane & 15, q = lane >> 4;
    const int h = unit & 15, tok0 = (unit >> 4) * 128;
    LAS bf16* VT = (LAS bf16*)lds;
    const int trow = 16 * w + c16, nks = (16 * w + 15) / 32 + 1;
    f32x4 wq[4][2];
#pragma unroll
    for (int ks = 0; ks < 4; ++ks) { wq[ks][0] = (f32x4){0.f, 0.f, 0.f, 0.f}; wq[ks][1] = wq[ks][0];
        if (ks < nks) { const float* wp = WSP + ((size_t)h * 128 + trow) * 128 + 32 * ks + 8 * q; wq[ks][0] = *(const f32x4*)wp; wq[ks][1] = *(const f32x4*)(wp + 4); } }
    v2u uq[8];
#pragma unroll
    for (int db = 0; db < 8; ++db) uq[db] = *(const v2u*)(PROJ + (size_t)(tok0 + 16 * w + c16) * DIN + h * 128 + 16 * db + 4 * q);
    {   const int c = tid & 15;
#pragma unroll
        for (int i = 0; i < 4; ++i) { const int s = (tid >> 4) + 32 * i;
            const v4u raw = *(const v4u*)(PROJ + (size_t)(tok0 + s) * DIN + 2048 + h * 128 + 8 * c);
            float f[8]; f[0] = bflo(raw.x); f[1] = bfhi(raw.x); f[2] = bflo(raw.y); f[3] = bfhi(raw.y); f[4] = bflo(raw.z); f[5] = bfhi(raw.z); f[6] = bflo(raw.w); f[7] = bfhi(raw.w);
            float ss = 0.f;
#pragma unroll
            for (int k = 0; k < 8; ++k) ss += f[k] * f[k];
            ss += __shfl_xor(ss, 1); ss += __shfl_xor(ss, 2); ss += __shfl_xor(ss, 4); ss += __shfl_xor(ss, 8);
            const float rs = 1.0f / sqrtf(ss * (1.0f / 128.0f) + EPS);
#pragma unroll
            for (int k = 0; k < 4; ++k) { const unsigned pk = cvtpk(f[2 * k] * rs, f[2 * k + 1] * rs);
                const int sp_ = (((s >> 3) ^ c) << 3) | (s & 7);
                VT[(8 * c + 2 * k) * 136 + sp_] = (bf16)(pk & 0xffffu); VT[(8 * c + 2 * k + 1) * 136 + sp_] = (bf16)(pk >> 16); } }
    }
    __syncthreads();
    f32x4 acc[8];
#pragma unroll
    for (int db = 0; db < 8; ++db) acc[db] = (f32x4){0.f, 0.f, 0.f, 0.f};
#pragma unroll
    for (int ks = 0; ks < 4; ++ks) if (ks < nks) {
        const f32x4 w0 = wq[ks][0], w1 = wq[ks][1];
        const int sb = 32 * ks + 8 * q;
        float wv[8] = {w0.x, w0.y, w0.z, w0.w, w1.x, w1.y, w1.z, w1.w};
#pragma unroll
        for (int j = 0; j < 8; ++j) wv[j] = (sb + j <= trow) ? wv[j] : 0.f;
        v4u wpk; wpk.x = cvtpk(wv[0], wv[1]); wpk.y = cvtpk(wv[2], wv[3]); wpk.z = cvtpk(wv[4], wv[5]); wpk.w = cvtpk(wv[6], wv[7]);
        const bf16x8 wf = __builtin_bit_cast(bf16x8, wpk);
#pragma unroll
        for (int db = 0; db < 8; ++db) { const bf16x8 vf = *(const LAS bf16x8*)(VT + (16 * db + c16) * 136 + (((4 * ks + q) ^ ((16 * db + c16) >> 3)) << 3));
            acc[db] = __builtin_amdgcn_mfma_f32_16x16x32_bf16(vf, wf, acc[db], 0, 0, 0); }
    }
    const int tok = tok0 + 16 * w + c16; const float bsp = BSP[h * 128 + 16 * w + c16]; float ssq = 0.f;
#pragma unroll
    for (int db = 0; db < 8; ++db) { const int dcol = h * 128 + 16 * db + 4 * q;
        const v2u ur = uq[db]; const f32x4 g = *(const f32x4*)(GV + dcol);
        const float y0 = bflo(ur.x) * (g.x * acc[db][0] + bsp), y1 = bfhi(ur.x) * (g.y * acc[db][1] + bsp), y2 = bflo(ur.y) * (g.z * acc[db][2] + bsp), y3 = bfhi(ur.y) * (g.w * acc[db][3] + bsp);
        ssq += (y0 * y0 + y1 * y1) + (y2 * y2 + y3 * y3);
        const f32x4 go = *(const f32x4*)(GOA + dcol); v2u o; o.x = cvtpk(y0 * go.x, y1 * go.y); o.y = cvtpk(y2 * go.z, y3 * go.w); *(v2u*)(Y + (size_t)tok * D + dcol) = o; }
    ssq += __shfl_xor(ssq, 16); ssq += __shfl_xor(ssq, 32);
    if (q == 0) SSA[(size_t)tok * 16 + h] = ssq;
    __syncthreads();
}

__device__ __forceinline__ void rglru_local_unit(LAS unsigned char* lds, int unit, const bf16* PROJ, const float* WR, const float* WI, const float* BR, const float* BI,
                                                 const float* WCONV, const float* BCONV, const float* SP, float* HL, float* PC, float* AGGP, float* AGGH) {
    const int tid = threadIdx.x, lane = tid & 63, w = __builtin_amdgcn_readfirstlane(tid >> 6), c16 = lane & 15, q = lane >> 4;
    const int n = unit & 15, tg = unit >> 4;
#pragma unroll 2
    for (int i = 0; i < 8; ++i) {
        const int f = tid + 512 * i, l2 = f & 63, ks = (f >> 6) & 3, eb = (f >> 8) & 7, mat = f >> 11, i2 = l2 & 15, q2 = l2 >> 4;
        const int e = 32 * (eb >> 1) + 8 * (i2 >> 2) + 4 * (eb & 1) + (i2 & 3);
        const float* src = (mat ? WI : WR) + ((size_t)n * 128 + 32 * ks + 8 * q2) * 128 + e;
        v4u o; o.x = cvtpk(src[0], src[128]); o.y = cvtpk(src[256], src[384]); o.z = cvtpk(src[512], src[640]); o.w = cvtpk(src[768], src[896]);
        *(LAS v4u*)(lds + (size_t)f * 16) = o;
    }
    __syncthreads();
    const int token0 = tg * 512 + w * 64, gc = token0 >> 6;
    LAS f32x2v* cst = (LAS f32x2v*)(lds + 65536 + w * 1024) + q * 32;
#pragma unroll
    for (int i = 0; i < 32; ++i) if (c16 == 15) cst[i] = (f32x2v){1.0f, 0.0f};
#pragma unroll 1
    for (int tb = 0; tb < 4; ++tb) {
        const int tok = token0 + 16 * tb + c16, s = tok & (SEQ - 1);
        int zo = 0; asm volatile("" : "+v"(zo));
        const float* BCONV_ = BCONV + zo; const float* WCONV_ = WCONV + zo; const float* BR_ = BR + zo; const float* BI_ = BI + zo; const float* SP_ = SP + zo;
        float xc[4][8]; bf16x8 xf[4];
#pragma unroll
        for (int ks = 0; ks < 4; ++ks) {
            const int ch0 = n * 128 + 32 * ks + 8 * q;
            const f32x4 b0 = *(const f32x4*)(BCONV_ + ch0), b1 = *(const f32x4*)(BCONV_ + ch0 + 4);
            float a[8] = {b0.x, b0.y, b0.z, b0.w, b1.x, b1.y, b1.z, b1.w};
#pragma unroll
            for (int k = 0; k < 4; ++k) {
                v4u raw = (v4u){0u, 0u, 0u, 0u};
                if (s - 3 + k >= 0) raw = *(const v4u*)(PROJ + (size_t)(tok - 3 + k) * DIN + 6144 + ch0);
                const f32x4 w0 = *(const f32x4*)(WCONV_ + k * 2048 + ch0), w1 = *(const f32x4*)(WCONV_ + k * 2048 + ch0 + 4);
                a[0] += w0.x * bflo(raw.x); a[1] += w0.y * bfhi(raw.x); a[2] += w0.z * bflo(raw.y); a[3] += w0.w * bfhi(raw.y);
                a[4] += w1.x * bflo(raw.z); a[5] += w1.y * bfhi(raw.z); a[6] += w1.z * bflo(raw.w); a[7] += w1.w * bfhi(raw.w);
            }
#pragma unroll
            for (int j = 0; j < 8; ++j) xc[ks][j] = a[j];
            v4u pk; pk.x = cvtpk(a[0], a[1]); pk.y = cvtpk(a[2], a[3]); pk.z = cvtpk(a[4], a[5]); pk.w = cvtpk(a[6], a[7]);
            xf[ks] = __builtin_bit_cast(bf16x8, pk);
        }
#pragma unroll
        for (int ebh = 0; ebh < 2; ++ebh) {
            f32x4 ar[4], ai[4];
#pragma unroll
            for (int e4 = 0; e4 < 4; ++e4) { ar[e4] = (f32x4){0.f, 0.f, 0.f, 0.f}; ai[e4] = (f32x4){0.f, 0.f, 0.f, 0.f}; }
#pragma unroll
            for (int e4 = 0; e4 < 4; ++e4)
#pragma unroll
                for (int ks = 0; ks < 4; ++ks) { const int eb = 4 * ebh + e4;
                    const bf16x8 wfr = *(const LAS bf16x8*)(lds + (size_t)(((0 * 8 + eb) * 4 + ks) * 64 + lane) * 16);
                    const bf16x8 wfi = *(const LAS bf16x8*)(lds + (size_t)(((1 * 8 + eb) * 4 + ks) * 64 + lane) * 16);
                    ar[e4] = __builtin_amdgcn_mfma_f32_16x16x32_bf16(wfr, xf[ks], ar[e4], 0, 0, 0);
                    ai[e4] = __builtin_amdgcn_mfma_f32_16x16x32_bf16(wfi, xf[ks], ai[e4], 0, 0, 0); }
#pragma unroll
            for (int e4 = 0; e4 < 4; ++e4) { const int eb = 4 * ebh + e4, ksx = eb >> 1, jj0 = 4 * (eb & 1), ch = n * 128 + 32 * ksx + 8 * q + jj0;
                const f32x4 br = *(const f32x4*)(BR_ + ch), bi = *(const f32x4*)(BI_ + ch), sp = *(const f32x4*)(SP_ + ch);
                f32x4 hv, pv;
#pragma unroll
                for (int j = 0; j < 4; ++j) {
                    const float r = sigmoidf_(ar[e4][j] + br[j]), ig = sigmoidf_(ai[e4][j] + bi[j]);
                    const float la = -8.0f * r * sp[j];
                    float a = fexp2(la * LOG2E);
                    const float x2 = 2.0f * la;
                    float pm = 1.0f / 720.0f; pm = pm * x2 + 1.0f / 120.0f; pm = pm * x2 + 1.0f / 24.0f; pm = pm * x2 + 1.0f / 6.0f; pm = pm * x2 + 0.5f; pm = pm * x2 + 1.0f; pm = pm * x2;
                    const float m2 = (x2 > -0.25f) ? -pm : (1.0f - a * a);
                    float b = sqrtf(fmaxf(m2, 1e-12f)) * (ig * xc[ksx][jj0 + j]);
                    { const float ap = dpp_f<0x111>(1.0f, a), bp = dpp_f<0x111>(0.0f, b); b = a * bp + b; a = a * ap; }
                    { const float ap = dpp_f<0x112>(1.0f, a), bp = dpp_f<0x112>(0.0f, b); b = a * bp + b; a = a * ap; }
                    { const float ap = dpp_f<0x114>(1.0f, a), bp = dpp_f<0x114>(0.0f, b); b = a * bp + b; a = a * ap; }
                    { const float ap = dpp_f<0x118>(1.0f, a), bp = dpp_f<0x118>(0.0f, b); b = a * bp + b; a = a * ap; }
                    const int ci = eb * 4 + j;
                    const f32x2v cr = cst[ci];
                    const float P = a * cr.x, H = b + a * cr.y;
                    pv[j] = P; hv[j] = H;
                    if (c16 == 15) cst[ci] = (f32x2v){P, H};
                }
                const size_t di = ((((size_t)gc * 16 + n) * 4 + tb) * 8 + eb) * 64 + lane;
                { v4u o; o.x = cvtpk(hv[0], hv[1]); o.y = cvtpk(hv[2], hv[3]); o.z = cvtpk(pv[0], pv[1]); o.w = cvtpk(pv[2], pv[3]); __builtin_nontemporal_store(o, (v4u*)HL + di); }
                if (tb == 3 && c16 == 15) { *(f32x4*)(AGGP + (size_t)gc * 2048 + ch) = pv; *(f32x4*)(AGGH + (size_t)gc * 2048 + ch) = hv; }
            }
        }
    }
    __syncthreads();
}

__device__ __forceinline__ void rglru_final_unit(int unit, const bf16* PROJ, const float* HL, const float* PC, const float* AGGP, const float* AGGH, const float* GOB, bf16* Y, float* SSB) {
    const int tid = threadIdx.x, lane = tid & 63, w = __builtin_amdgcn_readfirstlane(tid >> 6), c16 = lane & 15, q = lane >> 4;
    const int n = unit & 15, tg = unit >> 4;
    const int token0 = tg * 512 + w * 64, gc = token0 >> 6, cin = gc & 31, gb = gc - cin;
    float carry[32];
#pragma unroll
    for (int eb = 0; eb < 8; ++eb) { const int ch = n * 128 + 32 * (eb >> 1) + 8 * q + 4 * (eb & 1);
        f32x4 p0 = (f32x4){1.f, 1.f, 1.f, 1.f}, h0 = (f32x4){0.f, 0.f, 0.f, 0.f}, p1 = p0, h1 = h0;
        if (2 * c16 < cin) { p0 = *(const f32x4*)(AGGP + (size_t)(gb + 2 * c16) * 2048 + ch); h0 = *(const f32x4*)(AGGH + (size_t)(gb + 2 * c16) * 2048 + ch); }
        if (2 * c16 + 1 < cin) { p1 = *(const f32x4*)(AGGP + (size_t)(gb + 2 * c16 + 1) * 2048 + ch); h1 = *(const f32x4*)(AGGH + (size_t)(gb + 2 * c16 + 1) * 2048 + ch); }
#pragma unroll
        for (int j = 0; j < 4; ++j) {
            float a = p0[j] * p1[j], b = p1[j] * h0[j] + h1[j];
            { float ap = dpp_f<0x111>(1.0f, a), bp = dpp_f<0x111>(0.0f, b); ap = (c16 >= 1) ? ap : 1.0f; bp = (c16 >= 1) ? bp : 0.0f; b = a * bp + b; a = a * ap; }
            { float ap = dpp_f<0x112>(1.0f, a), bp = dpp_f<0x112>(0.0f, b); ap = (c16 >= 2) ? ap : 1.0f; bp = (c16 >= 2) ? bp : 0.0f; b = a * bp + b; a = a * ap; }
            { float ap = dpp_f<0x114>(1.0f, a), bp = dpp_f<0x114>(0.0f, b); ap = (c16 >= 4) ? ap : 1.0f; bp = (c16 >= 4) ? bp : 0.0f; b = a * bp + b; a = a * ap; }
            { float ap = dpp_f<0x118>(1.0f, a), bp = dpp_f<0x118>(0.0f, b); ap = (c16 >= 8) ? ap : 1.0f; bp = (c16 >= 8) ? bp : 0.0f; b = a * bp + b; a = a * ap; }
            carry[4 * eb + j] = __shfl(b, (lane & 48) | 15);
        }
    }
#pragma unroll 1
    for (int tb = 0; tb < 4; ++tb) {
        const int tok = token0 + 16 * tb + c16; float ssq = 0.f;
#pragma unroll
        for (int eb = 0; eb < 8; ++eb) { const int chl = 32 * (eb >> 1) + 8 * q + 4 * (eb & 1);
            const size_t di = ((((size_t)gc * 16 + n) * 4 + tb) * 8 + eb) * 64 + lane;
            const v4u hp = __builtin_nontemporal_load((const v4u*)HL + di); const f32x4 hv = (f32x4){bflo(hp.x), bfhi(hp.x), bflo(hp.y), bfhi(hp.y)}, pv = (f32x4){bflo(hp.z), bfhi(hp.z), bflo(hp.w), bfhi(hp.w)};
            const v2u gr = *(const v2u*)(PROJ + (size_t)tok * DIN + 4096 + n * 128 + chl);
            const float y0 = (hv[0] + pv[0] * carry[4 * eb + 0]) * bflo(gr.x), y1 = (hv[1] + pv[1] * carry[4 * eb + 1]) * bfhi(gr.x),
                        y2 = (hv[2] + pv[2] * carry[4 * eb + 2]) * bflo(gr.y), y3 = (hv[3] + pv[3] * carry[4 * eb + 3]) * bfhi(gr.y);
            ssq += (y0 * y0 + y1 * y1) + (y2 * y2 + y3 * y3);
            const f32x4 go = *(const f32x4*)(GOB + n * 128 + chl); v2u o; o.x = cvtpk(y0 * go.x, y1 * go.y); o.y = cvtpk(y2 * go.z, y3 * go.w); *(v2u*)(Y + (size_t)tok * D + 2048 + n * 128 + chl) = o; }
        ssq += __shfl_xor(ssq, 16); ssq += __shfl_xor(ssq, 32);
        if (q == 0) SSB[(size_t)tok * 16 + n] = ssq;
    }
}

#define XB_TMO      128
#define XB_XCNT(j)  (256  + 64 * (j))
#define XB_XSUB(j)  (1280 + 64 * (j))
#define XB_XGEN(j)  (2304 + 64 * (j))
#define XB_TOP      3328
#define XB_TOPGEN   3392
#define XCD_BAR_WORDS 3456
#define XB_SPIN_CAP (1u << 18)

__device__ __forceinline__ unsigned xb_ld(unsigned* p)              { return __hip_atomic_load(p, __ATOMIC_RELAXED, __HIP_MEMORY_SCOPE_AGENT); }
__device__ __forceinline__ unsigned xb_add(unsigned* p, unsigned v) { return __hip_atomic_fetch_add(p, v, __ATOMIC_RELAXED, __HIP_MEMORY_SCOPE_AGENT); }
__device__ __forceinline__ unsigned xb_xcc_id() { return (unsigned)__builtin_amdgcn_s_getreg((3 << 11) | 20) & 0xFu; }
#define XB_SPIN(cond, bar) do { unsigned _sp = 0; while (cond) { __builtin_amdgcn_s_sleep(1); \
    if ((++_sp & 255u) == 0u) { if (xb_ld(&(bar)[XB_TMO])) break; if (_sp > XB_SPIN_CAP) { atomicAdd(&(bar)[XB_TMO], 1u); break; } } } } while (0)

struct XcdBarrier {
    unsigned* bar; unsigned x;
    volatile LAS unsigned* st;
};

__device__ __forceinline__ XcdBarrier xcd_barrier_post(unsigned* bar, volatile LAS unsigned* st) {
    XcdBarrier b; b.bar = bar; b.x = xb_xcc_id(); b.st = st;
    if (threadIdx.x == 0) (void)xb_add(&bar[XB_XCNT(b.x)], 1u);
    return b;
}
__device__ __forceinline__ void xcd_barrier_complete(unsigned* bar, unsigned x, unsigned& nloc, unsigned& nx) {
    const unsigned G = gridDim.x * gridDim.y * gridDim.z;
    unsigned sum, cnt, mine, sp = 0u;
    for (;;) {
        sum = 0u; cnt = 0u; mine = 0u;
#pragma unroll
        for (unsigned j = 0; j < 16; ++j) { const unsigned c = xb_ld(&bar[XB_XCNT(j)]); sum += c; cnt += (c > 0u) ? 1u : 0u; mine = (j == x) ? c : mine; }
        if (sum == G) break;
        __builtin_amdgcn_s_sleep(1);
        if ((++sp & 255u) == 0u) { if (xb_ld(&bar[XB_TMO])) break; if (sp > XB_SPIN_CAP) { atomicAdd(&bar[XB_TMO], 1u); break; } }
    }
    nloc = mine > 0u ? mine : 1u; nx = cnt > 0u ? cnt : 1u;
}

__device__ __forceinline__ void xcd_barrier(const XcdBarrier& b) {
    asm volatile("s_waitcnt vmcnt(0)" ::: "memory");
    __syncthreads();
    if (threadIdx.x == 0) {
        unsigned* bar = b.bar;
        __builtin_amdgcn_s_waitcnt(0);
        unsigned nloc = b.st[0], nx = b.st[1];
        if (nloc == 0u) { xcd_barrier_complete(bar, b.x, nloc, nx); b.st[0] = nloc; b.st[1] = nx; }
        const unsigned old = xb_add(&bar[XB_XSUB(b.x)], 1u);
        const unsigned gen = old / nloc;
        if (old + 1u == (gen + 1u) * nloc) {
            __builtin_amdgcn_fence(__ATOMIC_RELEASE, "agent");
            asm volatile("s_waitcnt vmcnt(0)" ::: "memory");
            const unsigned og = xb_add(&bar[XB_TOP], 1u);
            const unsigned tg = og / nx;
            if (og + 1u == (tg + 1u) * nx) xb_add(&bar[XB_TOPGEN], 1u);
            else XB_SPIN(xb_ld(&bar[XB_TOPGEN]) == tg, bar);
            __builtin_amdgcn_fence(__ATOMIC_ACQUIRE, "agent");
            xb_add(&bar[XB_XGEN(b.x)], 1u);
            asm volatile("s_waitcnt vmcnt(0)" ::: "memory");
        } else {
            XB_SPIN(xb_ld(&bar[XB_XGEN(b.x)]) == gen, bar);
            __builtin_amdgcn_fence(__ATOMIC_ACQUIRE, "agent");
            asm volatile("s_waitcnt vmcnt(0)" ::: "memory");
        }
    }
    __syncthreads();
}

struct Args { const float* in[21]; float* out; unsigned char* ws; int ph_lo, ph_hi; };
constexpr int N_PHASES = 9;

__global__ void __launch_bounds__(NWAVES * 64, 2) mk_fwd(Args args) {
    extern __shared__ __attribute__((aligned(16))) unsigned char lds_raw[];
    LAS unsigned char* lds = (LAS unsigned char*)lds_raw;
    const int tid = threadIdx.x, lane = tid & 63, wave = __builtin_amdgcn_readfirstlane(tid >> 6);
    const int G = gridDim.x, bx = blockIdx.x, gw = bx * NWAVES + wave, NGW = G * NWAVES;
    unsigned char* ws = args.ws;
    const float* x = args.in[0]; float* out = args.out;
    bf16* WinT = (bf16*)(ws + WS_WIN); bf16* WoutT = (bf16*)(ws + WS_WOUT); bf16* WfiT = (bf16*)(ws + WS_WFI); bf16* WfoT = (bf16*)(ws + WS_WFO);
    bf16* XN = (bf16*)(ws + WS_XN); bf16* PROJ = (bf16*)(ws + WS_PROJ); bf16* Y = (bf16*)(ws + WS_Y); bf16* O1 = (bf16*)(ws + WS_O1); bf16* ACT = (bf16*)(ws + WS_ACT);
    float* HL = (float*)(ws + WS_HL); float* PC = (float*)(ws + WS_PC); bf16* FB = (bf16*)(ws + WS_PC); float* SSA = (float*)(ws + WS_SSA); float* SSB = (float*)(ws + WS_SSB);
    float* SS1 = (float*)(ws + WS_SS1); float* SS2 = (float*)(ws + WS_SS2); float* AGGP = (float*)(ws + WS_AGGP); float* AGGH = (float*)(ws + WS_AGGH); float* SP = (float*)(ws + WS_SP);
    const int lo = args.ph_lo, hi = args.ph_hi;
    if (hi > 1000) cg::this_grid().sync();
    volatile LAS unsigned* MISC = (volatile LAS unsigned*)(lds + MISC_OFF);
    if (tid < 64) MISC[tid] = 0u;
    __syncthreads();
    XcdBarrier bar; bar.bar = (unsigned*)(ws + WS_CTL); bar.x = 0; bar.st = nullptr;
    if (hi - lo > 1) bar = xcd_barrier_post((unsigned*)(ws + WS_CTL), MISC);
#ifndef PH_MASK
#define PH_MASK 0x1ff
#endif
#define IN(k) (((PH_MASK >> (k)) & 1) && lo <= (k) && (k) < hi)
#ifndef PROBE_DUP
#define PROBE_DUP 0
#endif
#ifndef PROBE_SYNC
#define PROBE_SYNC 1
#endif
#define NREP(k) (1 + ((PROBE_DUP >> (k)) & 1))
#define SEAM(k) do { if (IN(k) && IN((k) + 1)) { for (int r_ = 0; r_ < PROBE_SYNC; ++r_) xcd_barrier(bar); } } while (0)

    LAS float* scr = (LAS float*)(lds + wave * 16640);
    constexpr int I_IN = (D / 64) * (DIN / 64), I_OUT = (D / 64) * (D / 64), I_FI = (D / 64) * (2 * DFF / 64), I_FO = (DFF / 64) * (D / 64), NITEMS = I_IN + I_OUT + I_FI + I_FO;
    constexpr int CONV_WG_ITEMS = (I_OUT + I_FI) / 32;
    constexpr int CONV2_WG_ITEMS = I_FO / 32;
    static_assert((I_OUT + I_FI) % 32 == 0 && I_FO % 32 == 0, "deferred conversion items");
#define P0_DECODE(it_, src_, dst_, N_, K_) do { int r_ = (it_); \
            if (r_ < I_IN) { const int kb = r_ / (DIN / 64), nb = r_ % (DIN / 64); N_ = DIN; K_ = D; src_ = args.in[2] + (size_t)(64 * kb) * DIN + 64 * nb; dst_ = WinT + (size_t)(64 * nb) * D + 64 * kb; } \
            else if ((r_ -= I_IN) < I_OUT) { const int kb = r_ / (D / 64), nb = r_ % (D / 64); N_ = D; K_ = D; src_ = args.in[15] + (size_t)(64 * kb) * D + 64 * nb; dst_ = WoutT + (size_t)(64 * nb) * D + 64 * kb; } \
            else if ((r_ -= I_OUT) < I_FI) { const int kb = r_ / (2 * DFF / 64), nb = r_ % (2 * DFF / 64), n0d = 64 * nb, pn = n0d >> 8, within = n0d & 255; const int n0s = (within < 128 ? 0 : DFF) + 128 * pn + (within & 127); \
                N_ = 2 * DFF; K_ = D; src_ = args.in[18] + (size_t)(64 * kb) * (2 * DFF) + n0s; dst_ = WfiT + (size_t)n0d * D + 64 * kb; } \
            else { r_ -= I_FI; const int kb = r_ / (D / 64), nb = r_ % (D / 64); N_ = D; K_ = DFF; src_ = args.in[19] + (size_t)(64 * kb) * D + 64 * nb; dst_ = WfoT + (size_t)(64 * nb) * DFF + 64 * kb; } } while (0)
#define CONVERT_RANGE(first_, end_, stride_, nt_) do { \
            f32x4 nxt[16]; const float* src = nullptr; bf16* dst = nullptr; size_t N = 0, K = 0; \
            int it = (first_); bool have = it < (end_); \
            if (have) { P0_DECODE(it, src, dst, N, K); p0_load_item(nxt, src, N, lane); } \
            while (have) { \
                f32x4 cur[16]; \
                _Pragma("unroll") for (int i = 0; i < 16; ++i) cur[i] = nxt[i]; \
                bf16* cdst = dst; const size_t cK = K; \
                it += (stride_); have = it < (end_); \
                if (have) { P0_DECODE(it, src, dst, N, K); p0_load_item(nxt, src, N, lane); } \
                p0_store_item<nt_>(cur, cdst, cK, scr, lane); \
            } } while (0)
#define WG_FETCH(ctr_, out_) do { __syncthreads(); if (tid == 0) MISC[16] = __hip_atomic_fetch_add((ctr_), 1u, __ATOMIC_RELAXED, __HIP_MEMORY_SCOPE_AGENT); __syncthreads(); out_ = (int)MISC[16]; } while (0)

    if (IN(0)) for (int rep = 0; rep < NREP(0); ++rep) {
        CONVERT_RANGE(gw, I_IN, NGW, false);
        for (int m = gw; m < M; m += NGW) rms_row_to_bf16(x + (size_t)m * D, args.in[1], XN + (size_t)m * D, lane);
        for (int i = bx * 512 + tid; i < 2048; i += G * 512) SP[i] = log1pf(expf(-args.in[12][i]));
    }
    SEAM(0);
    if (IN(1)) for (int rep = 0; rep < NREP(1); ++rep) {
        pg8::Gemm g{XN, WinT, M, DIN, D}; pg8::StaticOrder S; S.init(M, DIN, G, bx);
        pg8::EpiProj E{PROJ};
        pg8::gemm_phase<pg8::EpiProj, pg8::StaticOrder, false, true>(lds, g, S, E);
    }
    SEAM(1);
    if (IN(2)) for (int rep = 0; rep < NREP(2); ++rep) {
        unsigned* qmix = (unsigned*)(ws + WS_CTL) + 8192 + 256 * rep; unsigned* qconv = qmix + 64;
        const bool conv_first = ((bx >> 3) & 7) >= 4;
        for (int pass = 0; pass < 2; ++pass) {
            if ((pass == 0) == conv_first) {
                for (;;) { int ci; WG_FETCH(qconv, ci); if (ci >= CONV_WG_ITEMS) break;
                    const int first = I_IN + ci * 32 + wave; CONVERT_RANGE(first, I_IN + ci * 32 + 32, 8, true); }
            } else {
                for (;;) { int u; WG_FETCH(qmix, u); if (u >= 1280) break;
                    if (u < 256) rglru_local_unit(lds, u, PROJ, args.in[8], args.in[10], args.in[9], args.in[11], args.in[6], args.in[7], SP, HL, PC, AGGP, AGGH);
                    else gmlp_unit(lds, u - 256, PROJ, args.in[4], args.in[5], args.in[3], args.in[13], Y, SSA); }
            }
        }
        __syncthreads();
    }
    SEAM(2);
    if (IN(3)) for (int rep = 0; rep < NREP(3); ++rep) {
        for (int u = bx; u < 256; u += G) rglru_final_unit(u, PROJ, HL, PC, AGGP, AGGH, args.in[14], Y, SSB);
    }
    SEAM(3);
    if (IN(4)) for (int rep = 0; rep < NREP(4); ++rep) {
        pg8::Gemm g{Y, WoutT, M, D, D}; pg8::StaticOrder S; S.init(M, D, G, bx);
        { pg8::Unit u;
          for (int i = 0; i < 8 && S.next(i, u); ++i) {
              if (tid < 256) { const int row = u.pm * 256 + tid; const f32x4* pa = (const f32x4*)(SSA + (size_t)row * 16); const f32x4* pb = (const f32x4*)(SSB + (size_t)row * 16);
                  float sa = 0.f, sb = 0.f;
#pragma unroll
                  for (int j = 0; j < 4; ++j) { const f32x4 a = pa[j], b = pb[j]; sa += (a.x + a.y) + (a.z + a.w); sb += (b.x + b.y) + (b.z + b.w); }
                  const float rsa = 1.0f / sqrtf(sa * (1.0f / DA) + EPS), rsb = 1.0f / sqrtf(sb * (1.0f / DA) + EPS);
                  *(LAS f32x2v*)(lds + RSL_OFF + (size_t)(i * 256 + tid) * 8) = (f32x2v){rsa / rsb, rsb}; } }
          __syncthreads(); }
        pg8::EpiRows<true> E{O1, SS1, lds + RSL_OFF};
        pg8::gemm_phase<pg8::EpiRows<true>, pg8::StaticOrder, false, true>(lds, g, S, E);
    }
    SEAM(4);
    if (IN(5)) for (int rep = 0; rep < NREP(5); ++rep) {
        for (int row = gw; row < M; row += NGW) {
            const float rs1 = 1.0f / sqrtf(wave_sum(SS1[(size_t)row * 64 + lane]) * (1.0f / D) + EPS);
            f32x4 x1[16]; float s2 = 0.f;
#pragma unroll
            for (int j = 0; j < 16; ++j) { const int col = 4 * lane + 256 * j;
                const f32x4 xv = __builtin_nontemporal_load((const f32x4*)(x + (size_t)row * D + col)); const v2u o = *(const v2u*)(O1 + (size_t)row * D + col); const f32x4 g = *(const f32x4*)(args.in[16] + col);
                f32x4 v; v.x = xv.x + bflo(o.x) * rs1 * g.x; v.y = xv.y + bfhi(o.x) * rs1 * g.y; v.z = xv.z + bflo(o.y) * rs1 * g.z; v.w = xv.w + bfhi(o.y) * rs1 * g.w;
                x1[j] = v; s2 += (v.x * v.x + v.y * v.y) + (v.z * v.z + v.w * v.w); }
            const float rs2 = 1.0f / sqrtf(wave_sum(s2) * (1.0f / D) + EPS);
#pragma unroll
            for (int j = 0; j < 16; ++j) { const int col = 4 * lane + 256 * j; const f32x4 g = *(const f32x4*)(args.in[17] + col);
                v2u o; o.x = cvtpk(x1[j].x * rs2 * g.x, x1[j].y * rs2 * g.y); o.y = cvtpk(x1[j].z * rs2 * g.z, x1[j].w * rs2 * g.w);
                *(v2u*)(XN + (size_t)row * D + col) = o; }
        }
    }
    SEAM(5);
    if (IN(6)) for (int rep = 0; rep < NREP(6); ++rep) {
        pg8::Gemm g{XN, WfiT, M, 2 * DFF, D}; pg8::StaticOrder S; S.init(M, 2 * DFF, G, bx);
        pg8::EpiSwiGLU E{ACT};
        pg8::gemm_phase<pg8::EpiSwiGLU, pg8::StaticOrder, false, true>(lds, g, S, E);
        { unsigned* qconv2 = (unsigned*)(ws + WS_CTL) + 8192 + 128 + 256 * rep;
          for (;;) { int ci; WG_FETCH(qconv2, ci); if (ci >= CONV2_WG_ITEMS) break;
              const int first = I_IN + I_OUT + I_FI + ci * 32 + wave; CONVERT_RANGE(first, I_IN + I_OUT + I_FI + ci * 32 + 32, 8, true); }
          __syncthreads(); }
    }
    SEAM(6);
    if (IN(7)) for (int rep = 0; rep < NREP(7); ++rep) {
        pg8::Gemm g{ACT, WfoT, M, D, DFF}; pg8::StaticOrder S; S.init(M, D, G, bx);
        pg8::EpiRows<false> E{FB, SS2, lds + RSL_OFF};
        pg8::gemm_phase<pg8::EpiRows<false>, pg8::StaticOrder, false, true>(lds, g, S, E);
    }
    SEAM(7);
    if (IN(8)) for (int rep = 0; rep < NREP(8); ++rep) {
        float* dst = (rep + 1 == NREP(8)) ? out : (float*)(ws + WS_HL);
        for (int row = gw; row < M; row += NGW) {
            const float rs = 1.0f / sqrtf(wave_sum(SS2[(size_t)row * 64 + lane]) * (1.0f / D) + EPS);
            const float rs1 = 1.0f / sqrtf(wave_sum(SS1[(size_t)row * 64 + lane]) * (1.0f / D) + EPS);
#pragma unroll
            for (int j = 0; j < 16; ++j) { const int col = 4 * lane + 256 * j;
                const f32x4 xv = __builtin_nontemporal_load((const f32x4*)(x + (size_t)row * D + col)); const v2u o1 = *(const v2u*)(O1 + (size_t)row * D + col); const f32x4 g1 = *(const f32x4*)(args.in[16] + col);
                const v2u o = *(const v2u*)(FB + (size_t)row * D + col); const f32x4 g = *(const f32x4*)(args.in[20] + col);
                f32x4 v; v.x = xv.x + bflo(o1.x) * rs1 * g1.x; v.y = xv.y + bfhi(o1.x) * rs1 * g1.y; v.z = xv.z + bflo(o1.y) * rs1 * g1.z; v.w = xv.w + bfhi(o1.y) * rs1 * g1.w;
                v.x = v.x + bflo(o.x) * rs * g.x; v.y = v.y + bfhi(o.x) * rs * g.y; v.z = v.z + bflo(o.y) * rs * g.z; v.w = v.w + bfhi(o.y) * rs * g.w;
                __builtin_nontemporal_store(v, (f32x4*)(dst + (size_t)row * D + col)); }
        }
    }
#undef IN
#undef SEAM
#undef P0_DECODE
#undef CONVERT_RANGE
#undef WG_FETCH
}

extern "C" void kernel_launch(void* const* d_in, const int* in_sizes, int n_in, void* d_out, int out_size, void* d_ws, size_t ws_size, hipStream_t stream) {
    static int grid = 0;
    if (grid == 0) {
        if (n_in != 21 || out_size != M * D || ws_size < WS_END) { fprintf(stderr, "kernel_launch: unexpected problem (n_in %d, out %d, ws %zu)\n", n_in, out_size, ws_size); grid = -1; return; }
        int dev = 0, cus = 0, per_cu = 0;
        if (hipGetDevice(&dev) != hipSuccess || hipDeviceGetAttribute(&cus, hipDeviceAttributeMultiprocessorCount, dev) != hipSuccess) { grid = -1; return; }
        if (hipFuncSetAttribute((const void*)mk_fwd, hipFuncAttributeMaxDynamicSharedMemorySize, LDS_BYTES) != hipSuccess) { fprintf(stderr, "kernel_launch: hipFuncSetAttribute failed\n"); grid = -1; return; }
        if (hipOccupancyMaxActiveBlocksPerMultiprocessor(&per_cu, (const void*)mk_fwd, NWAVES * 64, LDS_BYTES) != hipSuccess || per_cu < 1) per_cu = 1;
        (void)hipGetLastError();
        grid = cus * per_cu;
        fprintf(stderr, "kernel_launch: %d CUs x %d -> grid %d\n", cus, per_cu, grid);
    }
    if (grid < 0) return;
    if (hipMemsetAsync((char*)d_ws + WS_CTL, 0, CTL_ZERO_BYTES, stream) != hipSuccess) { fprintf(stderr, "kernel_launch: hipMemsetAsync failed\n"); return; }
    Args a{};
    for (int i = 0; i < 21; ++i) a.in[i] = (const float*)d_in[i];
    a.out = (float*)d_out; a.ws = (unsigned char*)d_ws;
#if MK_N_LAUNCHES == 1
    a.ph_lo = 0; a.ph_hi = N_PHASES;
    void* kargs[] = {&a};
    hipError_t e = hipLaunchCooperativeKernel((const void*)mk_fwd, dim3(grid), dim3(NWAVES * 64), kargs, LDS_BYTES, stream);
    if (e != hipSuccess) fprintf(stderr, "kernel_launch: cooperative launch failed: %s (grid %d)\n", hipGetErrorString(e), grid);
#else
    for (int p = 0; p < N_PHASES; ++p) { a.ph_lo = p; a.ph_hi = p + 1; hipLaunchKernelGGL(mk_fwd, dim3(grid), dim3(NWAVES * 64), LDS_BYTES, stream, a); }
#endif
}
```
